# Optimizing an MI355X kernel written in HIP

```python
import jax, jax.numpy as jnp
from jax import lax
import numpy as np

D_MODEL = 2048
BATCH = 8
SEQ = 2048
DEPTH = 1

ATT_HEADS = 16
ATT_KV_HEADS = 2
HEAD_DIM = 64
ATT_WIDTH = ATT_HEADS * HEAD_DIM
KV_WIDTH = ATT_KV_HEADS * HEAD_DIM
GROUP = ATT_HEADS // ATT_KV_HEADS
WINDOW = 128
BLOCK = 128
ROT_DIM = HEAD_DIM // 4
ROPE_THETA = 500000.0
HG_HEADS = 8
HG_EXPAND = 128
HG_HEAD_V = 128
HG_F_WIDTH = HG_HEADS * HG_EXPAND
HG_V_WIDTH = HG_HEADS * HG_HEAD_V
CHUNK = 64
N_LB = DEPTH + 1
FFN_HIDDEN = ((8 * D_MODEL // 3 + 255) // 256) * 256
N_MOD = 6
IN_COLS = ATT_WIDTH + 2 * KV_WIDTH + 2 * HG_F_WIDTH + 2 * HG_V_WIDTH + 2 * D_MODEL
EPS = 1e-6

kernel_name = "hybrid_swa_sink_hgrn2_gated_block"


def rmsnorm(t, gain):
    t32 = t.astype(jnp.float32)
    y = t32 * lax.rsqrt(jnp.mean(t32 * t32, axis=-1, keepdims=True) + EPS)
    return (y * gain.astype(jnp.float32)).astype(t.dtype)


def rope_partial(t, cos, sin):
    half = ROT_DIM // 2
    t1 = t[..., :half].astype(jnp.float32)
    t2 = t[..., half:ROT_DIM].astype(jnp.float32)
    rot = jnp.concatenate([t1 * cos - t2 * sin, t2 * cos + t1 * sin], axis=-1)
    return jnp.concatenate([rot.astype(t.dtype), t[..., ROT_DIM:]], axis=-1)


def sliding_window_attention(q, k, v, sinks):
    B, S = q.shape[0], q.shape[1]
    nb = S // BLOCK
    qb = q.reshape(B, nb, BLOCK, ATT_KV_HEADS, GROUP, HEAD_DIM).astype(jnp.float32)
    kb = k.reshape(B, nb, BLOCK, ATT_KV_HEADS, HEAD_DIM).astype(jnp.float32)
    vb = v.reshape(B, nb, BLOCK, ATT_KV_HEADS, HEAD_DIM).astype(jnp.float32)
    prev = lambda t: jnp.concatenate([jnp.zeros_like(t[:, :1]), t[:, :-1]], axis=1)
    kk = jnp.concatenate([prev(kb), kb], axis=2)
    vv = jnp.concatenate([prev(vb), vb], axis=2)
    logits = jnp.einsum('bnqhgd,bnkhd->bnhgqk', qb, kk) * (HEAD_DIM ** -0.5)
    qi = jnp.arange(BLOCK)[:, None]
    kj = jnp.arange(2 * BLOCK)[None, :]
    rel = BLOCK + qi - kj
    band = (rel >= 0) & (rel < WINDOW)
    has_prev = (jnp.arange(nb) > 0)[:, None, None] | (kj >= BLOCK)[None]
    mask = band[None] & has_prev
    logits = jnp.where(mask[None, :, None, None], logits, -jnp.inf)
    sink = sinks.astype(jnp.float32).reshape(ATT_KV_HEADS, GROUP)[None, None, :, :, None, None]
    m = jnp.maximum(jnp.max(logits, axis=-1, keepdims=True), sink)
    p = jnp.exp(logits - m)
    denom = jnp.sum(p, axis=-1, keepdims=True) + jnp.exp(sink - m)
    out = jnp.einsum('bnhgqk,bnkhd->bnqhgd', p / denom, vv)
    return out.reshape(B, S, ATT_WIDTH).astype(q.dtype)


def hgrn2_recurrence(q, f_raw, i, lb):
    B, S = q.shape[0], q.shape[1]
    nc = S // CHUNK
    f = lb + (1.0 - lb) * jax.nn.sigmoid(f_raw.astype(jnp.float32))
    key = 1.0 - f
    logf = jnp.log(f)

    def chunks(t, d):
        return t.astype(jnp.float32).reshape(B, nc, CHUNK, HG_HEADS, d).transpose(1, 0, 3, 2, 4)

    qc = chunks(jax.nn.silu(q.astype(jnp.float32)), HG_EXPAND)
    kc = chunks(key, HG_EXPAND)
    vc = chunks(i, HG_HEAD_V)
    bc = jnp.cumsum(chunks(logf, HG_EXPAND), axis=3)
    causal = jnp.tril(jnp.ones((CHUNK, CHUNK), dtype=bool))[:, :, None]

    def step(state, xs):
        qt, kt, vt, bt = xs
        o_inter = jnp.einsum('bhck,bhkv->bhcv', qt * jnp.exp(bt), state)
        diff = bt[:, :, :, None, :] - bt[:, :, None, :, :]
        decay = jnp.where(causal, jnp.exp(jnp.where(causal, diff, 0.0)), 0.0)
        scores = jnp.einsum('bhtk,bhtsk,bhsk->bhts', qt, decay, kt)
        o = o_inter + jnp.einsum('bhts,bhsv->bhtv', scores, vt)
        b_last = bt[:, :, -1:, :]
        new_state = (jnp.exp(b_last[:, :, 0, :])[..., None] * state
                     + jnp.einsum('bhsk,bhsv->bhkv', kt * jnp.exp(b_last - bt), vt))
        return new_state, o

    state0 = jnp.zeros((B, HG_HEADS, HG_EXPAND, HG_HEAD_V), jnp.float32)
    _, o = lax.scan(step, state0, (qc, kc, vc, bc))
    return o.transpose(1, 0, 3, 2, 4).reshape(B, S, HG_HEADS, HG_HEAD_V)


def setup_inputs(seed: int = 0) -> dict:
    key = jax.random.key(seed)
    ks = jax.random.split(key, 20)
    f32 = jnp.float32
    nrm = lambda k, shape, scale: (jax.random.normal(k, shape, f32) * scale)
    gain = lambda k, shape: 1.0 + 0.05 * jax.random.normal(k, shape, f32)
    offsets = jax.random.randint(ks[2], (BATCH, 1), 0, 4096, dtype=jnp.int32)
    positions = (offsets + jnp.arange(SEQ, dtype=jnp.int32)[None, :]).astype(jnp.int32)
    return {
        "x": nrm(ks[0], (BATCH, SEQ, D_MODEL), 1.0),
        "c": nrm(ks[1], (BATCH, D_MODEL), 1.0),
        "positions": positions,
        "w_ada": nrm(ks[3], (DEPTH, D_MODEL, N_MOD * D_MODEL), 0.5 * D_MODEL ** -0.5),
        "b_ada": nrm(ks[4], (DEPTH, N_MOD * D_MODEL), 0.02),
        "g_pre_mix": gain(ks[5], (DEPTH, D_MODEL)),
        "g_post_mix": gain(ks[6], (DEPTH, D_MODEL)),
        "g_pre_ffn": gain(ks[7], (DEPTH, D_MODEL)),
        "g_post_ffn": gain(ks[8], (DEPTH, D_MODEL)),
        "w_in": nrm(ks[9], (DEPTH, D_MODEL, IN_COLS), D_MODEL ** -0.5),
        "attn_sinks": nrm(ks[10], (DEPTH, ATT_HEADS), 1.0),
        "w_attn_proj": nrm(ks[11], (DEPTH, ATT_WIDTH, D_MODEL), ATT_WIDTH ** -0.5),
        "hg_lower_bounds": nrm(ks[12], (N_LB, HG_F_WIDTH), 0.5),
        "hg_norm": gain(ks[13], (DEPTH, HG_HEAD_V)),
        "w_hgrn_proj": nrm(ks[14], (DEPTH, HG_V_WIDTH, D_MODEL), HG_V_WIDTH ** -0.5),
        "w_out": nrm(ks[15], (DEPTH, D_MODEL, D_MODEL), D_MODEL ** -0.5),
        "w_ffn_in": nrm(ks[16], (DEPTH, D_MODEL, 2 * FFN_HIDDEN), D_MODEL ** -0.5),
        "w_ffn_out": nrm(ks[17], (DEPTH, FFN_HIDDEN, D_MODEL), FFN_HIDDEN ** -0.5),
    }


def reference(x, c, positions, w_ada, b_ada, g_pre_mix, g_post_mix, g_pre_ffn, g_post_ffn,
              w_in, attn_sinks, w_attn_proj, hg_lower_bounds, hg_norm, w_hgrn_proj, w_out,
              w_ffn_in, w_ffn_out):
    B, S = x.shape[0], x.shape[1]
    inv_freq = ROPE_THETA ** (-jnp.arange(0, ROT_DIM, 2, dtype=jnp.float32) / ROT_DIM)
    ang = positions.astype(jnp.float32)[..., None] * inv_freq
    cos, sin = jnp.cos(ang)[:, :, None, :], jnp.sin(ang)[:, :, None, :]
    lb_table = jnp.cumsum(jax.nn.softmax(hg_lower_bounds.astype(jnp.float32), axis=0), axis=0)
    splits = [ATT_WIDTH, ATT_WIDTH + KV_WIDTH, ATT_WIDTH + 2 * KV_WIDTH,
              ATT_WIDTH + 2 * KV_WIDTH + HG_F_WIDTH,
              ATT_WIDTH + 2 * KV_WIDTH + 2 * HG_F_WIDTH,
              ATT_WIDTH + 2 * KV_WIDTH + 2 * HG_F_WIDTH + HG_V_WIDTH,
              ATT_WIDTH + 2 * KV_WIDTH + 2 * HG_F_WIDTH + 2 * HG_V_WIDTH,
              ATT_WIDTH + 2 * KV_WIDTH + 2 * HG_F_WIDTH + 2 * HG_V_WIDTH + D_MODEL]
    for l in range(DEPTH):
        mod = (c @ w_ada[l] + b_ada[l])[:, None, :]
        shift1, scale1, gate1, shift2, scale2, gate2 = jnp.split(mod, N_MOD, axis=-1)

        h = rmsnorm(x, g_pre_mix[l]) * (1.0 + scale1) + shift1
        proj = h @ w_in[l]
        q_a, k_a, v_a, q_h, f_h, i_h, g_h, gate_a, gate_h = jnp.split(proj, splits, axis=-1)
        qa = rope_partial(q_a.reshape(B, S, ATT_HEADS, HEAD_DIM), cos, sin)
        ka = rope_partial(k_a.reshape(B, S, ATT_KV_HEADS, HEAD_DIM), cos, sin)
        va = v_a.reshape(B, S, ATT_KV_HEADS, HEAD_DIM)
        y_a = sliding_window_attention(qa, ka, va, attn_sinks[l]) @ w_attn_proj[l]
        o_h = hgrn2_recurrence(q_h, f_h, i_h, lb_table[l])
        o_h = rmsnorm(o_h, hg_norm[l]).reshape(B, S, HG_V_WIDTH).astype(x.dtype)
        y_h = (o_h * jax.nn.sigmoid(g_h)) @ w_hgrn_proj[l]
        merged = jax.nn.sigmoid(gate_a) * y_a + jax.nn.sigmoid(gate_h) * y_h
        y = merged @ w_out[l]
        x = x + gate1 * rmsnorm(y, g_post_mix[l])

        h = rmsnorm(x, g_pre_ffn[l]) * (1.0 + scale2) + shift2
        gu = h @ w_ffn_in[l]
        g_ffn, u_ffn = jnp.split(gu, 2, axis=-1)
        y = (jax.nn.silu(g_ffn) * u_ffn) @ w_ffn_out[l]
        x = x + gate2 * rmsnorm(y, g_post_ffn[l])
    return x
```

```cpp
#include <hip/hip_runtime.h>
#include <cstdio>
#include <cstdint>

#ifndef MK_N_LAUNCHES
#define MK_N_LAUNCHES 1
#endif

#define LAS __attribute__((address_space(3)))
#define GAS __attribute__((address_space(1)))
typedef unsigned short bf16_t;
typedef short bf16x8 __attribute__((ext_vector_type(8)));
typedef float f32x4 __attribute__((ext_vector_type(4)));
typedef float f32x2 __attribute__((ext_vector_type(2)));
typedef unsigned u32x4 __attribute__((ext_vector_type(4)));
typedef unsigned u32x2 __attribute__((ext_vector_type(2)));

constexpr int NWAVES = 8;
constexpr int NB = 8, SEQ = 2048, DM = 2048, MTOK = NB * SEQ;
constexpr int AW = 1024, KVW = 128, HGW = 1024, FFH = 5632, INC = 9472, NMODC = 6 * DM;
constexpr float EPS = 1e-6f;
constexpr float LOG2E = 1.4426950408889634f;
constexpr float QSCALE = 0.125f * 1.4426950408889634f;

__device__ __forceinline__ unsigned cvt_pk_bf16(float lo, float hi) { unsigned r; asm("v_cvt_pk_bf16_f32 %0, %1, %2" : "=v"(r) : "v"(lo), "v"(hi)); return r; }
__device__ __forceinline__ float bflo(unsigned w) { return __uint_as_float(w << 16); }
__device__ __forceinline__ float bfhi(unsigned w) { return __uint_as_float(w & 0xffff0000u); }
__device__ __forceinline__ float bf2f(bf16_t h) { return __uint_as_float((unsigned)h << 16); }
__device__ __forceinline__ float fsigmoid(float x) { return 1.0f / (1.0f + __expf(-x)); }
__device__ __forceinline__ u32x4 pack8(f32x4 a, f32x4 b) { u32x4 w; w.x = cvt_pk_bf16(a[0], a[1]); w.y = cvt_pk_bf16(a[2], a[3]); w.z = cvt_pk_bf16(b[0], b[1]); w.w = cvt_pk_bf16(b[2], b[3]); return w; }
__device__ __forceinline__ void unpack8(u32x4 w, f32x4& a, f32x4& b) { a = (f32x4){bflo(w.x), bfhi(w.x), bflo(w.y), bfhi(w.y)}; b = (f32x4){bflo(w.z), bfhi(w.z), bflo(w.w), bfhi(w.w)}; }

namespace pg8 {
constexpr int BM = 256, BK = 64, HALF = 128, HTB = HALF * BK * 2  , STAGE_BYTES = 8 * HTB, NXCD = 8, WGM = 8;

__host__ __device__ __forceinline__ int lds_byte(int r, int c) { const int st = (r >> 4) * 2 + (c >> 5), rr = r & 15, cc = c & 31, ob = rr * 64 + cc * 2; return st * 1024 + (ob ^ (((ob >> 9) & 1) << 5)); }
__host__ __device__ __forceinline__ void stage_rc(int b, int& R, int& C) { const int st = b / 1024, sb = b % 1024, swz = sb ^ (((sb >> 9) & 1) << 5); R = (st >> 1) * 16 + swz / 64; C = (st & 1) * 32 + (swz % 64) / 2; }
__host__ __device__ __forceinline__ int perm32(int rho) { const int n = rho >> 4, i = rho & 15; return 8 * (i >> 2) + 4 * n + (i & 3); }

struct Unit { int pm, pn, sub; };

struct StaticOrder {
    int nM, nN, nwg, G, c;
    __host__ __device__ void init(int M, int N, int G_, int c_) { nM = M / BM; nN = N / BM; nwg = nM * nN; G = G_; c = c_; }
    __host__ __device__ bool next(int i, Unit& u) const {
        const long L = (long)i * G + c; if (L >= nwg) return false;
        int wgid = (int)L; { const int q = nwg / NXCD, r = nwg % NXCD, xcd = wgid % NXCD, off = wgid / NXCD; wgid = (xcd < r ? xcd * (q + 1) : r * (q + 1) + (xcd - r) * q) + off; }
        const int nig = WGM * nN, gid = wgid / nig, fm = gid * WGM, gsz = (nM - fm) < WGM ? (nM - fm) : WGM;
        u.pm = fm + ((wgid % nig) % gsz); u.pn = (wgid % nig) / gsz; u.sub = 0; return true;
    }
};
struct SingleOrder {
    StaticOrder so; const char* A; const char* B; size_t tstep;
    __device__ __forceinline__ bool next(int i, Unit& u) const { return so.next(i, u); }
    __device__ __forceinline__ const char* aptr(const Unit& u) const { return A + (size_t)u.pm * tstep; }
    __device__ __forceinline__ const char* bptr(const Unit& u) const { return B + (size_t)u.pn * tstep; }
};
struct DualOrder {
    StaticOrder so; const char *A0, *B0, *A1, *B1; size_t tstep;
    __device__ __forceinline__ bool next(int i, Unit& u) const { if (!so.next(i >> 1, u)) return false; u.sub = i & 1; return true; }
    __device__ __forceinline__ const char* aptr(const Unit& u) const { return (u.sub ? A1 : A0) + (size_t)u.pm * tstep; }
    __device__ __forceinline__ const char* bptr(const Unit& u) const { return (u.sub ? B1 : B0) + (size_t)u.pn * tstep; }
};

typedef f32x4 Acc[2][2][4][2];

template <class Epi, class Sched, bool ALIGN_EPI, bool SP2>
__device__ __forceinline__ void gemm_phase(LAS unsigned char* lds, const int K, const Sched& S, const Epi& E) {
    const int tid = threadIdx.x, wid = __builtin_amdgcn_readfirstlane(tid >> 6), lane = tid & 63, wr = wid >> 2, wc = wid & 3, fr = lane & 15, fq = lane >> 4;
    const int nt = K / BK;
    unsigned voffA[2], voffB[2];
#pragma unroll
    for (int i = 0; i < 2; ++i) { int R, C; stage_rc(tid * 16 + i * 8192, R, C); const int Rb = ((R & ~31) + perm32(R & 31));
        voffA[i] = (unsigned)(R * K + C) * 2u; voffB[i] = (unsigned)(Rb * K + C) * 2u; }
    const size_t kstep = (size_t)(BK * 2);
    const size_t hstep = (size_t)HALF * K * 2;
    const unsigned ldsw = (unsigned)wid * 1024u;
    const int aoff = lds_byte(wr * 64 + fr, fq * 8), boff = lds_byte(wc * 32 + fr, fq * 8);
#define PG8_SA(b, h) (((b) * 2 + (h)) * HTB)
#define PG8_SB(b, h) ((4 + (b) * 2 + (h)) * HTB)
#define PG8_STAGE(bufoff, gbase, voff) do { _Pragma("unroll") for (int _i = 0; _i < 2; ++_i) \
        __builtin_amdgcn_global_load_lds((const unsigned*)((const char*)(gbase) + (voff)[_i]), (LAS unsigned*)(lds + (bufoff) + ldsw + _i * 8192), 16, 0, 0); } while (0)
#define PG8_LDA(dst, b, h) do { _Pragma("unroll") for (int m = 0; m < 4; ++m) _Pragma("unroll") for (int k = 0; k < 2; ++k) dst[m][k] = *(const LAS bf16x8*)(lds + PG8_SA(b, h) + aoff + m * 2048 + k * 1024); } while (0)
#define PG8_LDB(dst, b, h) do { _Pragma("unroll") for (int n = 0; n < 2; ++n) _Pragma("unroll") for (int k = 0; k < 2; ++k) dst[n][k] = *(const LAS bf16x8*)(lds + PG8_SB(b, h) + boff + n * 2048 + k * 1024); } while (0)
#define PG8_MMA(ai, bj, At, Bt) do { __builtin_amdgcn_s_setprio(1); _Pragma("unroll") for (int m = 0; m < 4; ++m) _Pragma("unroll") for (int n = 0; n < 2; ++n) _Pragma("unroll") for (int k = 0; k < 2; ++k) \
        acc[ai][bj][m][n] = __builtin_amdgcn_mfma_f32_16x16x32_bf16(Bt[n][k], At[m][k], acc[ai][bj][m][n], 0, 0, 0); __builtin_amdgcn_s_setprio(0); } while (0)
#define PG8_WAIT_V(n) asm volatile("s_waitcnt vmcnt(" #n ")" ::: "memory")
#define PG8_WAIT_L(n) asm volatile("s_waitcnt lgkmcnt(" #n ")" ::: "memory")
#define PG8_BAR __builtin_amdgcn_s_barrier()
#define PG8_SCHED __builtin_amdgcn_sched_barrier(0)
    Unit cur, nxt; int ui = 0;
    if (!S.next(0, cur)) return;
    Acc acc;
#pragma unroll
    for (int a = 0; a < 2; ++a)
#pragma unroll
        for (int b = 0; b < 2; ++b)
#pragma unroll
            for (int m = 0; m < 4; ++m)
#pragma unroll
                for (int n = 0; n < 2; ++n) acc[a][b][m][n] = (f32x4){0.f, 0.f, 0.f, 0.f};
    bf16x8 At[4][2], B0[2][2], B1[2][2];
    const char* cA = S.aptr(cur); const char* cB = S.bptr(cur);
    if constexpr (SP2) {
        PG8_STAGE(PG8_SB(0, 0), cB, voffB); PG8_STAGE(PG8_SB(0, 1), cB + hstep, voffB); PG8_STAGE(PG8_SA(0, 0), cA, voffA); PG8_STAGE(PG8_SA(0, 1), cA + hstep, voffA);
        if (wr == 1) PG8_BAR;
        PG8_WAIT_V(2); PG8_BAR;
        PG8_STAGE(PG8_SB(1, 0), cB + kstep, voffB); PG8_STAGE(PG8_SA(1, 0), cA + kstep, voffA); PG8_STAGE(PG8_SB(1, 1), cB + hstep + kstep, voffB);
        PG8_WAIT_V(6); PG8_BAR;
    } else {
        PG8_STAGE(PG8_SB(0, 0), cB, voffB); PG8_STAGE(PG8_SA(0, 0), cA, voffA); PG8_STAGE(PG8_SB(0, 1), cB + hstep, voffB); PG8_STAGE(PG8_SA(0, 1), cA + hstep, voffA);
        if (wr == 1) PG8_BAR;
        PG8_WAIT_V(4); PG8_BAR;
        PG8_STAGE(PG8_SB(1, 0), cB + kstep, voffB); PG8_STAGE(PG8_SA(1, 0), cA + kstep, voffA); PG8_STAGE(PG8_SB(1, 1), cB + hstep + kstep, voffB);
        PG8_WAIT_V(6); PG8_BAR;
    }
    for (;;) {
        const bool has_next = S.next(ui + 1, nxt);
        const char* nA = has_next ? S.aptr(nxt) : cA; const char* nB = has_next ? S.bptr(nxt) : cB;
        for (int t = 0; t < nt; t += 2) {
            const bool last = (t == nt - 2);
            const char* a1 = cA + (size_t)(t + 1) * kstep;
            const char* a2 = last ? nA : cA + (size_t)(t + 2) * kstep; const char* b2 = last ? nB : cB + (size_t)(t + 2) * kstep;
            const char* a3 = a2 + kstep; const char* b3 = b2 + kstep;
            if constexpr (SP2) {
            PG8_LDB(B0, 0, 0); PG8_LDB(B1, 0, 1); PG8_SCHED; PG8_LDA(At, 0, 0); PG8_STAGE(PG8_SA(1, 1), a1 + hstep, voffA);
            PG8_WAIT_V(8); PG8_WAIT_L(0); PG8_BAR; PG8_MMA(0, 0, At, B0); PG8_MMA(0, 1, At, B1); PG8_BAR; PG8_SCHED;
            PG8_LDA(At, 0, 1); PG8_STAGE(PG8_SB(0, 0), b2, voffB); PG8_STAGE(PG8_SB(0, 1), b2 + hstep, voffB); PG8_STAGE(PG8_SA(0, 0), a2, voffA);
            PG8_WAIT_V(8); PG8_WAIT_L(0); PG8_BAR; PG8_MMA(1, 0, At, B0); PG8_MMA(1, 1, At, B1); PG8_BAR; PG8_SCHED;
            PG8_LDB(B0, 1, 0); PG8_LDB(B1, 1, 1); PG8_SCHED; PG8_LDA(At, 1, 0); PG8_STAGE(PG8_SA(0, 1), a2 + hstep, voffA);
            PG8_WAIT_V(8); PG8_WAIT_L(0); PG8_BAR; PG8_MMA(0, 0, At, B0); PG8_MMA(0, 1, At, B1); PG8_BAR; PG8_SCHED;
            PG8_LDA(At, 1, 1); PG8_STAGE(PG8_SB(1, 0), b3, voffB); PG8_STAGE(PG8_SB(1, 1), b3 + hstep, voffB); PG8_STAGE(PG8_SA(1, 0), a3, voffA);
            PG8_WAIT_V(8); PG8_WAIT_L(0); PG8_BAR; PG8_MMA(1, 0, At, B0); PG8_MMA(1, 1, At, B1); PG8_BAR; PG8_SCHED;
            } else {
            PG8_LDB(B0, 0, 0); PG8_SCHED; PG8_LDA(At, 0, 0); PG8_STAGE(PG8_SA(1, 1), a1 + hstep, voffA);
            PG8_WAIT_L(8); PG8_BAR; PG8_WAIT_L(0); PG8_MMA(0, 0, At, B0); PG8_BAR; PG8_SCHED;
            PG8_LDB(B1, 0, 1); PG8_STAGE(PG8_SB(0, 0), b2, voffB);
            PG8_BAR; PG8_WAIT_L(0); PG8_MMA(0, 1, At, B1); PG8_BAR;
            PG8_LDA(At, 0, 1); PG8_STAGE(PG8_SA(0, 0), a2, voffA);
            PG8_BAR; PG8_WAIT_L(0); PG8_MMA(1, 0, At, B0); PG8_BAR; PG8_SCHED;
            PG8_STAGE(PG8_SB(0, 1), b2 + hstep, voffB);
            PG8_WAIT_V(6); PG8_BAR; PG8_MMA(1, 1, At, B1); PG8_BAR;
            PG8_LDB(B0, 1, 0); PG8_SCHED; PG8_LDA(At, 1, 0); PG8_STAGE(PG8_SA(0, 1), a2 + hstep, voffA);
            PG8_WAIT_L(8); PG8_BAR; PG8_WAIT_L(0); PG8_MMA(0, 0, At, B0); PG8_BAR; PG8_SCHED;
            PG8_LDB(B1, 1, 1); PG8_STAGE(PG8_SB(1, 0), b3, voffB);
            PG8_BAR; PG8_WAIT_L(0); PG8_MMA(0, 1, At, B1); PG8_BAR;
            PG8_LDA(At, 1, 1); PG8_STAGE(PG8_SA(1, 0), a3, voffA);
            PG8_BAR; PG8_WAIT_L(0); PG8_MMA(1, 0, At, B0); PG8_BAR; PG8_SCHED;
            PG8_STAGE(PG8_SB(1, 1), b3 + hstep, voffB);
            PG8_WAIT_V(6); PG8_BAR; PG8_MMA(1, 1, At, B1); PG8_BAR;
            }
        }
        if constexpr (ALIGN_EPI) { if (wr == 0) PG8_BAR; }
        E(acc, cur, wr, wc, fr, fq);
        if (!has_next) break;
        if (!Epi::keep_acc(cur)) {
#pragma unroll
        for (int a = 0; a < 2; ++a)
#pragma unroll
            for (int b = 0; b < 2; ++b)
#pragma unroll
                for (int m = 0; m < 4; ++m)
#pragma unroll
                    for (int n = 0; n < 2; ++n) acc[a][b][m][n] = (f32x4){0.f, 0.f, 0.f, 0.f};
        }
        cur = nxt; cA = nA; cB = nB; ++ui;
        if constexpr (ALIGN_EPI) { if (wr == 1) PG8_BAR; }
    }
    PG8_WAIT_V(0);
    if constexpr (!ALIGN_EPI) { if (wr == 0) PG8_BAR; }
    PG8_BAR;
#undef PG8_SA
#undef PG8_SB
#undef PG8_STAGE
#undef PG8_LDA
#undef PG8_LDB
#undef PG8_MMA
#undef PG8_WAIT_V
#undef PG8_WAIT_L
#undef PG8_BAR
#undef PG8_SCHED
}
}

constexpr size_t MiB = 1u << 20;
constexpr size_t WS_CTL = 0, CTL_ZERO_BYTES = 64 * 1024;
constexpr size_t WS_MOD = 1 * MiB;
constexpr size_t WS_LB = 1 * MiB + 512 * 1024;
constexpr size_t WS_ROPE = 2 * MiB;
constexpr size_t WS_WIN = 4 * MiB, WS_WAP = 41 * MiB, WS_WHP = 45 * MiB, WS_WOUT = 49 * MiB, WS_WFI = 57 * MiB, WS_WFO = 101 * MiB;
constexpr size_t WS_QA = 128 * MiB, WS_QH = 160 * MiB, WS_KH = 192 * MiB, WS_LF = 224 * MiB, WS_IH = 256 * MiB, WS_GH = 288 * MiB;
constexpr size_t WS_KA = 320 * MiB, WS_VA = 324 * MiB, WS_GA = 328 * MiB, WS_GHT = 392 * MiB;
constexpr size_t WS_MERGED = 192 * MiB;
constexpr size_t WS_Y = 128 * MiB;
constexpr size_t WS_H2 = 256 * MiB;
constexpr size_t WS_ACT = 328 * MiB;
constexpr size_t WS_Y2 = 128 * MiB;
constexpr size_t WS_END = 504 * MiB;
constexpr size_t OUT_XN = 0, OUT_ORAW = 0, OUT_US = 64 * MiB;

constexpr int CW_BAR = 4096;

constexpr int RING_BYTES = 131072;
constexpr int LDSCTL_OFF = RING_BYTES, MISC_OFF = LDSCTL_OFF + 320;
constexpr int LDS_BYTES = 147456;

#define RLX_AGENT __ATOMIC_RELAXED, __HIP_MEMORY_SCOPE_AGENT
#define LDS_WAIT() asm volatile("s_waitcnt lgkmcnt(0)" ::: "memory")

#define XB_TMO      128
#define XB_XCNT(j)  (256  + 64 * (j))
#define XB_XSUB(j)  (1280 + 64 * (j))
#define XB_XGEN(j)  (2304 + 64 * (j))
#define XB_TOP      3328
#define XB_TOPGEN   3392
#define XCD_BAR_WORDS 3456
#define XB_SPIN_CAP (1u << 22)

__device__ __forceinline__ unsigned xb_ld(unsigned* p)              { return __hip_atomic_load(p, __ATOMIC_RELAXED, __HIP_MEMORY_SCOPE_AGENT); }
__device__ __forceinline__ unsigned xb_add(unsigned* p, unsigned v) { return __hip_atomic_fetch_add(p, v, __ATOMIC_RELAXED, __HIP_MEMORY_SCOPE_AGENT); }
__device__ __forceinline__ unsigned xb_xcc_id() { return (unsigned)__builtin_amdgcn_s_getreg((3 << 11) | 20) & 0xFu; }
#define XB_SPIN(cond, bar) do { unsigned _sp = 0; while (cond) { __builtin_amdgcn_s_sleep(1); \
    if ((++_sp & 255u) == 0u) { if (xb_ld(&(bar)[XB_TMO])) break; if (_sp > XB_SPIN_CAP) { atomicAdd(&(bar)[XB_TMO], 1u); break; } } } } while (0)

struct XcdBarrier { unsigned* bar; unsigned x; volatile LAS unsigned* st; };

__device__ __forceinline__ XcdBarrier xcd_barrier_post(unsigned* bar, volatile LAS unsigned* st) {
    XcdBarrier b; b.bar = bar; b.x = xb_xcc_id(); b.st = st;
    if (threadIdx.x == 0) (void)xb_add(&bar[XB_XCNT(b.x)], 1u);
    return b;
}
__device__ __forceinline__ void xcd_barrier_complete(unsigned* bar, unsigned x, unsigned& nloc, unsigned& nx) {
    const unsigned G = gridDim.x * gridDim.y * gridDim.z;
    unsigned sum, cnt, mine, sp = 0u;
    for (;;) {
        sum = 0u; cnt = 0u; mine = 0u;
#pragma unroll
        for (unsigned j = 0; j < 16; ++j) { const unsigned c = xb_ld(&bar[XB_XCNT(j)]); sum += c; cnt += (c > 0u) ? 1u : 0u; mine = (j == x) ? c : mine; }
        if (sum == G) break;
        __builtin_amdgcn_s_sleep(1);
        if ((++sp & 255u) == 0u) { if (xb_ld(&bar[XB_TMO])) break; if (sp > XB_SPIN_CAP) { atomicAdd(&bar[XB_TMO], 1u); break; } }
    }
    nloc = mine > 0u ? mine : 1u; nx = cnt > 0u ? cnt : 1u;
}
__device__ __forceinline__ void xcd_barrier(const XcdBarrier& b) {
    asm volatile("s_waitcnt vmcnt(0)" ::: "memory");
    __syncthreads();
    if (threadIdx.x == 0) {
        unsigned* bar = b.bar;
        __builtin_amdgcn_s_waitcnt(0);
        unsigned nloc = b.st[0], nx = b.st[1];
        if (nloc == 0u) { xcd_barrier_complete(bar, b.x, nloc, nx); b.st[0] = nloc; b.st[1] = nx; }
        const unsigned old = xb_add(&bar[XB_XSUB(b.x)], 1u);
        const unsigned gen = old / nloc;
        if (old + 1u == (gen + 1u) * nloc) {
            __builtin_amdgcn_fence(__ATOMIC_RELEASE, "agent");
            asm volatile("s_waitcnt vmcnt(0)" ::: "memory");
            const unsigned og = xb_add(&bar[XB_TOP], 1u);
            const unsigned tg = og / nx;
            if (og + 1u == (tg + 1u) * nx) xb_add(&bar[XB_TOPGEN], 1u);
            else XB_SPIN(xb_ld(&bar[XB_TOPGEN]) == tg, bar);
            __builtin_amdgcn_fence(__ATOMIC_ACQUIRE, "agent");
            xb_add(&bar[XB_XGEN(b.x)], 1u);
            asm volatile("s_waitcnt vmcnt(0)" ::: "memory");
        } else {
            XB_SPIN(xb_ld(&bar[XB_XGEN(b.x)]) == gen, bar);
            __builtin_amdgcn_fence(__ATOMIC_ACQUIRE, "agent");
            asm volatile("s_waitcnt vmcnt(0)" ::: "memory");
        }
    }
    __syncthreads();
}

struct Frame {
    LAS unsigned char* lds;
    int tid, lane, wave, vcu, G;
    const float *x, *c, *w_ada, *b_ada, *g_pre_mix, *g_post_mix, *g_pre_ffn, *g_post_ffn, *w_in, *sinks, *w_ap, *hg_lb, *hg_norm, *w_hp, *w_out, *w_fi, *w_fo;
    const int* positions;
    float* out;
    unsigned char* ws;
};
#define WSP(T, off) ((T*)(F.ws + (off)))

__device__ __forceinline__ float wave_sum(float v) {
#pragma unroll
    for (int o = 1; o < 64; o <<= 1) v += __shfl_xor(v, o);
    return v;
}

__device__ __forceinline__ int win_dst(int n) {
    if (n < AW + KVW) { int p = n & 63; if (p >= 4 && p < 12) p = (p < 8) ? p + 4 : p - 4; return (n & ~63) + p; }
    return n;
}
__device__ __forceinline__ int wfi_dst(int n) {
    if (n < FFH) return 256 * (n >> 7) + (n & 127);
    n -= FFH; return 256 * (n >> 7) + 128 + (n & 127);
}
__device__ __forceinline__ unsigned f2bf(float f) { unsigned u = __builtin_bit_cast(unsigned, f); return (u + 0x7fffu + ((u >> 16) & 1u)) >> 16; }
__device__ __forceinline__ unsigned pk2(float lo, float hi) { return f2bf(lo) | (f2bf(hi) << 16); }
template <int MODE>
__device__ __forceinline__ void p0_transpose_item(const float* W, int K, int N, bf16_t* WT, LAS float* scr, int item, int lane) {
    const int nblk = N / 32, kb = item / nblk, nb = item % nblk, k0 = 64 * kb, n0 = 32 * nb;
#pragma unroll 8
    for (int i = 0; i < 32; ++i) { const int kk = 2 * i + (lane >> 5); scr[kk * 33 + (lane & 31)] = W[(size_t)(k0 + kk) * N + n0 + (lane & 31)]; }
    LDS_WAIT(); asm volatile("" ::: "memory");
    const int c = lane & 7;
#pragma unroll
    for (int j = 0; j < 4; ++j) { const int n = (lane >> 3) + 8 * j; const LAS float* s = scr + (8 * c) * 33 + n;
        u32x4 o; o.x = pk2(s[0 * 33], s[1 * 33]); o.y = pk2(s[2 * 33], s[3 * 33]); o.z = pk2(s[4 * 33], s[5 * 33]); o.w = pk2(s[6 * 33], s[7 * 33]);
        const int nn = n0 + n; const int row = (MODE == 1) ? win_dst(nn) : (MODE == 2) ? wfi_dst(nn) : nn;
        *(u32x4*)(WT + (size_t)row * K + k0 + 8 * c) = o; }
    LDS_WAIT(); asm volatile("" ::: "memory");
}
__device__ __forceinline__ void p0_convert_item(Frame& F, LAS float* scr, int it) {
    constexpr int I_IN = (DM / 64) * (INC / 32), I_AP = (AW / 64) * (DM / 32), I_HP = (HGW / 64) * (DM / 32), I_OUT = (DM / 64) * (DM / 32), I_FI = (DM / 64) * (2 * FFH / 32);
    int r = it;
    if (r < I_IN) { p0_transpose_item<1>(F.w_in, DM, INC, WSP(bf16_t, WS_WIN), scr, r, F.lane); return; } r -= I_IN;
    if (r < I_AP) { p0_transpose_item<0>(F.w_ap, AW, DM, WSP(bf16_t, WS_WAP), scr, r, F.lane); return; } r -= I_AP;
    if (r < I_HP) { p0_transpose_item<0>(F.w_hp, HGW, DM, WSP(bf16_t, WS_WHP), scr, r, F.lane); return; } r -= I_HP;
    if (r < I_OUT) { p0_transpose_item<0>(F.w_out, DM, DM, WSP(bf16_t, WS_WOUT), scr, r, F.lane); return; } r -= I_OUT;
    if (r < I_FI) { p0_transpose_item<2>(F.w_fi, DM, 2 * FFH, WSP(bf16_t, WS_WFI), scr, r, F.lane); return; } r -= I_FI;
    p0_transpose_item<0>(F.w_fo, FFH, DM, WSP(bf16_t, WS_WFO), scr, r, F.lane);
}
constexpr int N_CONV_ITEMS = (DM / 64) * (INC / 32) + 2 * (AW / 64) * (DM / 32) + (DM / 64) * (DM / 32) + (DM / 64) * (2 * FFH / 32) + (FFH / 64) * (DM / 32);
constexpr int N_MOD_ITEMS = NMODC / 64;

__device__ __forceinline__ double rope_rev(int f) {
    switch (f) { case 0: return 0.15915494309189535; case 1: return 0.03086376340470123; case 2: return 0.005985185712713705; case 3: return 0.001160663641240061;
                 case 4: return 0.00022507907903927653; case 5: return 4.364795279280289e-05; case 6: return 8.464330808241401e-06; default: return 1.6414262627950345e-06; }
}

__device__ __forceinline__ void p0_prologue(Frame& F) {
    for (int idx = blockIdx.x * 512 + F.tid; idx < MTOK * 8; idx += F.G * 512) {
        const int m = idx >> 3, f = idx & 7;
        const double rev = (double)F.positions[m] * rope_rev(f);
        const float fr = (float)(rev - floor(rev));
        float* rp = WSP(float, WS_ROPE) + (size_t)m * 16;
        rp[f] = __builtin_amdgcn_cosf(fr); rp[8 + f] = __builtin_amdgcn_sinf(fr);
        if (idx < HGW) { const float a0 = F.hg_lb[idx], a1 = F.hg_lb[HGW + idx]; WSP(float, WS_LB)[idx] = 1.0f / (1.0f + __expf(a1 - a0)); }
    }
    if ((int)blockIdx.x < N_MOD_ITEMS) {
        const int item = blockIdx.x;
        LAS float* cT = (LAS float*)F.lds + F.wave * 2048;
        LAS float* red = (LAS float*)(F.lds + 65536);
        const int k0 = F.wave * 256;
#pragma unroll 4
        for (int i = 0; i < 32; ++i) { const int idx = i * 64 + F.lane; cT[idx] = F.c[(idx & 7) * DM + k0 + (idx >> 3)]; }
        LDS_WAIT(); asm volatile("" ::: "memory");
        float acc[8];
#pragma unroll
        for (int b = 0; b < 8; ++b) acc[b] = 0.f;
        const float* wp = F.w_ada + (size_t)k0 * NMODC + item * 64 + F.lane;
#pragma unroll 16
        for (int k = 0; k < 256; ++k) {
            const float w = wp[(size_t)k * NMODC];
            const f32x4 c0 = *(const LAS f32x4*)(cT + k * 8), c1 = *(const LAS f32x4*)(cT + k * 8 + 4);
            acc[0] += w * c0[0]; acc[1] += w * c0[1]; acc[2] += w * c0[2]; acc[3] += w * c0[3];
            acc[4] += w * c1[0]; acc[5] += w * c1[1]; acc[6] += w * c1[2]; acc[7] += w * c1[3];
        }
#pragma unroll
        for (int b = 0; b < 8; ++b) red[(F.wave * 8 + b) * 64 + F.lane] = acc[b];
        __syncthreads();
        float s = F.b_ada[item * 64 + F.lane];
#pragma unroll
        for (int w = 0; w < 8; ++w) s += red[(w * 8 + F.wave) * 64 + F.lane];
        WSP(float, WS_MOD)[F.wave * NMODC + item * 64 + F.lane] = s;
        __syncthreads();
    }
    LAS float* scr = (LAS float*)(F.lds + F.wave * 16384);
    if ((int)blockIdx.x >= N_MOD_ITEMS) {
        const int base = ((int)blockIdx.x - N_MOD_ITEMS) * 64 + F.wave * 8;
        for (int j = 0; j < 8; ++j) p0_convert_item(F, scr, base + j);
    }
    const int first = ((int)F.G > N_MOD_ITEMS) ? ((int)F.G - N_MOD_ITEMS) * 64 : 0;
    for (int it = first + blockIdx.x * NWAVES + F.wave; it < N_CONV_ITEMS; it += F.G * NWAVES) p0_convert_item(F, scr, it);
}

__device__ __forceinline__ void p1_rows(Frame& F) {
    const int gw = blockIdx.x * NWAVES + F.wave, NGW = F.G * NWAVES;
    bf16_t* XN = (bf16_t*)((unsigned char*)F.out + OUT_XN);
    for (int r0 = gw * 8; r0 < MTOK; r0 += NGW * 8) {
        const int b = r0 / SEQ;
        const float* mod = WSP(float, WS_MOD) + (size_t)b * NMODC;
        f32x4 ga[8], sh[8];
#pragma unroll
        for (int j = 0; j < 8; ++j) { const int col = 4 * F.lane + 256 * j;
            const f32x4 g = *(const f32x4*)(F.g_pre_mix + col), sc = *(const f32x4*)(mod + DM + col); sh[j] = *(const f32x4*)(mod + col); ga[j] = g * (1.0f + sc); }
        for (int r = r0; r < r0 + 8; ++r) {
            const float* xr = F.x + (size_t)r * DM;
            f32x4 v[8]; float ss = 0.f;
#pragma unroll
            for (int j = 0; j < 8; ++j) { v[j] = *(const f32x4*)(xr + 4 * F.lane + 256 * j); ss += (v[j][0] * v[j][0] + v[j][1] * v[j][1]) + (v[j][2] * v[j][2] + v[j][3] * v[j][3]); }
            const float rstd = rsqrtf(wave_sum(ss) * (1.0f / DM) + EPS);
            bf16_t* orow = XN + (size_t)r * DM;
#pragma unroll
            for (int j = 0; j < 8; ++j) { const f32x4 h = v[j] * rstd * ga[j] + sh[j]; u32x2 w; w.x = cvt_pk_bf16(h[0], h[1]); w.y = cvt_pk_bf16(h[2], h[3]); *(u32x2*)(orow + 4 * F.lane + 256 * j) = w; }
        }
    }
}

struct EpiG1 {
    unsigned char* ws; const float* rope; const float* lbv;
    static __device__ __forceinline__ bool keep_acc(const pg8::Unit&) { return false; }
    __device__ __forceinline__ void operator()(pg8::Acc& acc, const pg8::Unit& u, int wr, int wc, int fr, int fq) const {
        const int pn = u.pn; const int row0 = u.pm * 256 + wr * 64 + fr; const int cl = wc * 32 + 8 * fq;
        if (pn <= 4) {
            const bool dorope = ((wc & 1) == 0) && (fq < 2);
#pragma unroll
            for (int ai = 0; ai < 2; ++ai)
#pragma unroll
                for (int m = 0; m < 4; ++m) { const int row = row0 + ai * 128 + m * 16;
                    f32x4 cs = (f32x4){1.f, 1.f, 1.f, 1.f}, sn = (f32x4){0.f, 0.f, 0.f, 0.f};
                    if (dorope) { const float* rp = rope + (size_t)row * 16 + 4 * fq; cs = *(const f32x4*)rp; sn = *(const f32x4*)(rp + 8); }
#pragma unroll
                    for (int bj = 0; bj < 2; ++bj) { f32x4 v0 = acc[ai][bj][m][0], v1 = acc[ai][bj][m][1];
                        const bool isv = (pn == 4 && bj == 1);
                        if (dorope && !isv) { const f32x4 n0 = v0 * cs - v1 * sn, n1 = v1 * cs + v0 * sn; v0 = n0; v1 = n1; }
                        bf16_t* dst;
                        if (pn < 4) { v0 = v0 * QSCALE; v1 = v1 * QSCALE; dst = (bf16_t*)(ws + WS_QA) + (size_t)row * AW + pn * 256 + bj * 128 + cl; }
                        else dst = (bf16_t*)(ws + (bj == 0 ? WS_KA : WS_VA)) + (size_t)row * KVW + cl;
                        *(u32x4*)dst = pack8(v0, v1); } }
        } else if (pn <= 8) {
#pragma unroll
            for (int ai = 0; ai < 2; ++ai)
#pragma unroll
                for (int m = 0; m < 4; ++m) { const int row = row0 + ai * 128 + m * 16;
#pragma unroll
                    for (int bj = 0; bj < 2; ++bj) { f32x4 v0 = acc[ai][bj][m][0], v1 = acc[ai][bj][m][1];
#pragma unroll
                        for (int e = 0; e < 4; ++e) { v0[e] = v0[e] * fsigmoid(v0[e]); v1[e] = v1[e] * fsigmoid(v1[e]); }
                        *(u32x4*)((bf16_t*)(ws + WS_QH) + (size_t)row * HGW + (pn - 5) * 256 + bj * 128 + cl) = pack8(v0, v1); } }
        } else if (pn <= 12) {
#pragma unroll
            for (int bj = 0; bj < 2; ++bj) { const int col = (pn - 9) * 256 + bj * 128 + cl;
                const f32x4 lb0 = *(const f32x4*)(lbv + col), lb1 = *(const f32x4*)(lbv + col + 4);
#pragma unroll
                for (int ai = 0; ai < 2; ++ai)
#pragma unroll
                    for (int m = 0; m < 4; ++m) { const int row = row0 + ai * 128 + m * 16;
                        const f32x4 x0 = acc[ai][bj][m][0], x1 = acc[ai][bj][m][1]; f32x4 k0, k1, l0, l1;
#pragma unroll
                        for (int e = 0; e < 4; ++e) {
                            { const float xx = fminf(fmaxf(x0[e], -30.f), 30.f), ex = __expf(-xx), sg = 1.0f / (1.0f + ex), om = 1.0f - lb0[e]; k0[e] = om * (ex * sg); l0[e] = __logf(lb0[e] + om * sg); }
                            { const float xx = fminf(fmaxf(x1[e], -30.f), 30.f), ex = __expf(-xx), sg = 1.0f / (1.0f + ex), om = 1.0f - lb1[e]; k1[e] = om * (ex * sg); l1[e] = __logf(lb1[e] + om * sg); } }
                        *(u32x4*)((bf16_t*)(ws + WS_KH) + (size_t)row * HGW + col) = pack8(k0, k1);
                        *(u32x4*)((bf16_t*)(ws + WS_LF) + (size_t)row * HGW + col) = pack8(l0, l1); } }
        } else {
            bf16_t* base; int ldc, colt;
            if (pn <= 16) { base = (bf16_t*)(ws + WS_IH); ldc = HGW; colt = (pn - 13) * 256; }
            else if (pn <= 20) { base = (bf16_t*)(ws + WS_GH); ldc = HGW; colt = (pn - 17) * 256; }
            else if (pn <= 28) { base = (bf16_t*)(ws + WS_GA); ldc = DM; colt = (pn - 21) * 256; }
            else { base = (bf16_t*)(ws + WS_GHT); ldc = DM; colt = (pn - 29) * 256; }
            const bool sig = pn > 16;
#pragma unroll
            for (int ai = 0; ai < 2; ++ai)
#pragma unroll
                for (int m = 0; m < 4; ++m) { const int row = row0 + ai * 128 + m * 16;
#pragma unroll
                    for (int bj = 0; bj < 2; ++bj) { f32x4 v0 = acc[ai][bj][m][0], v1 = acc[ai][bj][m][1];
                        if (sig) {
#pragma unroll
                            for (int e = 0; e < 4; ++e) { v0[e] = fsigmoid(v0[e]); v1[e] = fsigmoid(v1[e]); } }
                        *(u32x4*)(base + (size_t)row * ldc + colt + bj * 128 + cl) = pack8(v0, v1); } }
        }
    }
};
struct EpiMerge {
    const bf16_t* ga; const bf16_t* gh; bf16_t* out;
    static __device__ __forceinline__ bool keep_acc(const pg8::Unit& u) { return u.sub == 0; }
    __device__ __forceinline__ void operator()(pg8::Acc& acc, const pg8::Unit& u, int wr, int wc, int fr, int fq) const {
        const int row0 = u.pm * 256 + wr * 64 + fr; const int col0 = u.pn * 256 + wc * 32 + 8 * fq;
#pragma unroll
        for (int ai = 0; ai < 2; ++ai)
#pragma unroll
            for (int m = 0; m < 4; ++m) { const size_t ro = (size_t)(row0 + ai * 128 + m * 16) * DM + col0;
#pragma unroll
                for (int bj = 0; bj < 2; ++bj) { f32x4 h0, h1; unpack8(*(const u32x4*)(gh + ro + bj * 128), h0, h1);
                    if (u.sub == 0) { f32x4 a0, a1; unpack8(*(const u32x4*)(ga + ro + bj * 128), a0, a1);
#pragma unroll
                        for (int e = 0; e < 4; ++e) { acc[ai][bj][m][0][e] *= a0[e] / h0[e]; acc[ai][bj][m][1][e] *= a1[e] / h1[e]; }
                    } else *(u32x4*)(out + ro + bj * 128) = pack8(acc[ai][bj][m][0] * h0, acc[ai][bj][m][1] * h1); } }
    }
};
struct EpiPlain {
    bf16_t* out; int ldc;
    static __device__ __forceinline__ bool keep_acc(const pg8::Unit&) { return false; }
    __device__ __forceinline__ void operator()(pg8::Acc& acc, const pg8::Unit& u, int wr, int wc, int fr, int fq) const {
        const int row0 = u.pm * 256 + wr * 64 + fr; const int col0 = u.pn * 256 + wc * 32 + 8 * fq;
#pragma unroll
        for (int ai = 0; ai < 2; ++ai)
#pragma unroll
            for (int m = 0; m < 4; ++m) { bf16_t* rp = out + (size_t)(row0 + ai * 128 + m * 16) * ldc + col0;
#pragma unroll
                for (int bj = 0; bj < 2; ++bj) *(u32x4*)(rp + bj * 128) = pack8(acc[ai][bj][m][0], acc[ai][bj][m][1]); }
    }
};
struct EpiSwiGLU {
    bf16_t* out;
    static __device__ __forceinline__ bool keep_acc(const pg8::Unit&) { return false; }
    __device__ __forceinline__ void operator()(pg8::Acc& acc, const pg8::Unit& u, int wr, int wc, int fr, int fq) const {
        const int row0 = u.pm * 256 + wr * 64 + fr; const int col0 = u.pn * 128 + wc * 32 + 8 * fq;
#pragma unroll
        for (int ai = 0; ai < 2; ++ai)
#pragma unroll
            for (int m = 0; m < 4; ++m) { f32x4 v0, v1;
#pragma unroll
                for (int e = 0; e < 4; ++e) { const float g0 = acc[ai][0][m][0][e], g1 = acc[ai][0][m][1][e]; v0[e] = g0 * fsigmoid(g0) * acc[ai][1][m][0][e]; v1[e] = g1 * fsigmoid(g1) * acc[ai][1][m][1][e]; }
                *(u32x4*)(out + (size_t)(row0 + ai * 128 + m * 16) * FFH + col0) = pack8(v0, v1); }
    }
};

__device__ __forceinline__ void attn_naive(Frame& F) {
    bf16_t* QA = WSP(bf16_t, WS_QA); const bf16_t* KA = WSP(bf16_t, WS_KA); const bf16_t* VA = WSP(bf16_t, WS_VA);
    for (int it = blockIdx.x * 512 + F.tid; it < MTOK * 16; it += F.G * 512) {
        const int m = it >> 4, hq = it & 15, b = m >> 11, s = m & 2047, kvh = hq >> 3;
        float q[64], o[64];
        bf16_t* qp = QA + (size_t)m * AW + hq * 64;
#pragma unroll
        for (int c = 0; c < 8; ++c) { const u32x4 w = *(const u32x4*)(qp + 8 * c); f32x4 a, bb; unpack8(w, a, bb);
#pragma unroll
            for (int e = 0; e < 4; ++e) { q[8 * c + e] = a[e]; q[8 * c + 4 + e] = bb[e]; } }
#pragma unroll
        for (int d = 0; d < 64; ++d) o[d] = 0.f;
        float mrun = F.sinks[hq] * LOG2E, den = 1.f;
        const int j0 = s >= 127 ? s - 127 : 0;
        for (int j = j0; j <= s; ++j) {
            const bf16_t* kr = KA + (size_t)(b * SEQ + j) * KVW + kvh * 64; const bf16_t* vr = VA + (size_t)(b * SEQ + j) * KVW + kvh * 64;
            float l = 0.f;
#pragma unroll
            for (int c = 0; c < 8; ++c) { f32x4 a, bb; unpack8(*(const u32x4*)(kr + 8 * c), a, bb);
#pragma unroll
                for (int e = 0; e < 4; ++e) { l += q[8 * c + e] * a[e]; l += q[8 * c + 4 + e] * bb[e]; } }
            const float mn = fmaxf(mrun, l), sc = exp2f(mrun - mn), p = exp2f(l - mn);
            den = den * sc + p; mrun = mn;
#pragma unroll
            for (int c = 0; c < 8; ++c) { f32x4 a, bb; unpack8(*(const u32x4*)(vr + 8 * c), a, bb);
#pragma unroll
                for (int e = 0; e < 4; ++e) { o[8 * c + e] = o[8 * c + e] * sc + p * a[e]; o[8 * c + 4 + e] = o[8 * c + 4 + e] * sc + p * bb[e]; } }
        }
        const float inv = 1.0f / den;
#pragma unroll
        for (int c = 0; c < 8; ++c) { f32x4 a, bb;
#pragma unroll
            for (int e = 0; e < 4; ++e) { a[e] = o[8 * c + e] * inv; bb[e] = o[8 * c + 4 + e] * inv; }
            *(u32x4*)(qp + 8 * c) = pack8(a, bb); }
    }
}
__device__ __forceinline__ void hgrn_naive_scan(Frame& F) {
    if (F.wave != 0 || (int)blockIdx.x >= 128) return;
    const int item = blockIdx.x, bh = item >> 1, vh = item & 1, b = bh >> 3, h = bh & 7;
    const bf16_t* QH = WSP(bf16_t, WS_QH); const bf16_t* KH = WSP(bf16_t, WS_KH); const bf16_t* LF = WSP(bf16_t, WS_LF); const bf16_t* IH = WSP(bf16_t, WS_IH);
    float* ORAW = (float*)((unsigned char*)F.out + OUT_ORAW);
    float st[128];
#pragma unroll
    for (int k = 0; k < 128; ++k) st[k] = 0.f;
    for (int t = 0; t < SEQ; ++t) {
        const size_t ro = (size_t)(b * SEQ + t) * HGW + h * 128;
        const float v = bf2f(IH[ro + vh * 64 + F.lane]);
        float o = 0.f;
#pragma unroll
        for (int c = 0; c < 16; ++c) { f32x4 q0, q1, k0, k1, l0, l1;
            unpack8(*(const u32x4*)(QH + ro + 8 * c), q0, q1); unpack8(*(const u32x4*)(KH + ro + 8 * c), k0, k1); unpack8(*(const u32x4*)(LF + ro + 8 * c), l0, l1);
#pragma unroll
            for (int e = 0; e < 4; ++e) {
                { const float f = exp2f(l0[e] * LOG2E); st[8 * c + e] = f * st[8 * c + e] + k0[e] * v; o += st[8 * c + e] * q0[e]; }
                { const float f = exp2f(l1[e] * LOG2E); st[8 * c + 4 + e] = f * st[8 * c + 4 + e] + k1[e] * v; o += st[8 * c + 4 + e] * q1[e]; } } }
        ORAW[ro + vh * 64 + F.lane] = o;
    }
}
__device__ __forceinline__ void hgrn_naive_finish(Frame& F) {
    const float* ORAW = (const float*)((unsigned char*)F.out + OUT_ORAW);
    bf16_t* HO = WSP(bf16_t, WS_QH); const bf16_t* GH = WSP(bf16_t, WS_GH);
    const int gw = blockIdx.x * NWAVES + F.wave, NGW = F.G * NWAVES;
    for (int it = gw; it < MTOK * 8; it += NGW) {
        const size_t ro = (size_t)(it >> 3) * HGW + (it & 7) * 128 + 2 * F.lane;
        const f32x2 o = *(const f32x2*)(ORAW + ro);
        const float rstd = rsqrtf(wave_sum(o[0] * o[0] + o[1] * o[1]) * (1.0f / 128.0f) + EPS);
        const f32x2 g = *(const f32x2*)(F.hg_norm + 2 * F.lane);
        const unsigned gw2 = *(const unsigned*)(GH + ro);
        *(unsigned*)(HO + ro) = cvt_pk_bf16(o[0] * rstd * g[0] * bflo(gw2), o[1] * rstd * g[1] * bfhi(gw2));
    }
}

__device__ __forceinline__ void rows2(Frame& F) {
    const int gw = blockIdx.x * NWAVES + F.wave, NGW = F.G * NWAVES;
    const bf16_t* Y = WSP(bf16_t, WS_Y); bf16_t* H2 = WSP(bf16_t, WS_H2);
    for (int r0 = gw * 8; r0 < MTOK; r0 += NGW * 8) {
        const int b = r0 / SEQ;
        const float* mod = WSP(float, WS_MOD) + (size_t)b * NMODC;
        f32x4 g1[8], ga[8], sh[8];
#pragma unroll
        for (int j = 0; j < 8; ++j) { const int col = 4 * F.lane + 256 * j;
            g1[j] = *(const f32x4*)(mod + 2 * DM + col) * *(const f32x4*)(F.g_post_mix + col);
            ga[j] = *(const f32x4*)(F.g_pre_ffn + col) * (1.0f + *(const f32x4*)(mod + 4 * DM + col)); sh[j] = *(const f32x4*)(mod + 3 * DM + col); }
        for (int r = r0; r < r0 + 8; ++r) {
            const float* xr = F.x + (size_t)r * DM; const bf16_t* yr = Y + (size_t)r * DM;
            f32x4 v[8], y[8]; float ss = 0.f;
#pragma unroll
            for (int j = 0; j < 8; ++j) { v[j] = *(const f32x4*)(xr + 4 * F.lane + 256 * j); const u32x2 w = *(const u32x2*)(yr + 4 * F.lane + 256 * j);
                y[j] = (f32x4){bflo(w.x), bfhi(w.x), bflo(w.y), bfhi(w.y)}; ss += (y[j][0] * y[j][0] + y[j][1] * y[j][1]) + (y[j][2] * y[j][2] + y[j][3] * y[j][3]); }
            const float rstd = rsqrtf(wave_sum(ss) * (1.0f / DM) + EPS);
            float s2 = 0.f; float* orow = F.out + (size_t)r * DM;
#pragma unroll
            for (int j = 0; j < 8; ++j) { v[j] = v[j] + g1[j] * (y[j] * rstd); *(f32x4*)(orow + 4 * F.lane + 256 * j) = v[j];
                s2 += (v[j][0] * v[j][0] + v[j][1] * v[j][1]) + (v[j][2] * v[j][2] + v[j][3] * v[j][3]); }
            const float rstd2 = rsqrtf(wave_sum(s2) * (1.0f / DM) + EPS);
            bf16_t* hrow = H2 + (size_t)r * DM;
#pragma unroll
            for (int j = 0; j < 8; ++j) { const f32x4 h = v[j] * rstd2 * ga[j] + sh[j]; u32x2 w; w.x = cvt_pk_bf16(h[0], h[1]); w.y = cvt_pk_bf16(h[2], h[3]); *(u32x2*)(hrow + 4 * F.lane + 256 * j) = w; }
        }
    }
}
__device__ __forceinline__ void rows3(Frame& F) {
    const int gw = blockIdx.x * NWAVES + F.wave, NGW = F.G * NWAVES;
    const bf16_t* Y2 = WSP(bf16_t, WS_Y2);
    for (int r0 = gw * 8; r0 < MTOK; r0 += NGW * 8) {
        const int b = r0 / SEQ;
        const float* mod = WSP(float, WS_MOD) + (size_t)b * NMODC;
        f32x4 g2[8];
#pragma unroll
        for (int j = 0; j < 8; ++j) { const int col = 4 * F.lane + 256 * j; g2[j] = *(const f32x4*)(mod + 5 * DM + col) * *(const f32x4*)(F.g_post_ffn + col); }
        for (int r = r0; r < r0 + 8; ++r) {
            float* orow = F.out + (size_t)r * DM; const bf16_t* yr = Y2 + (size_t)r * DM;
            f32x4 v[8], y[8]; float ss = 0.f;
#pragma unroll
            for (int j = 0; j < 8; ++j) { v[j] = *(const f32x4*)(orow + 4 * F.lane + 256 * j); const u32x2 w = *(const u32x2*)(yr + 4 * F.lane + 256 * j);
                y[j] = (f32x4){bflo(w.x), bfhi(w.x), bflo(w.y), bfhi(w.y)}; ss += (y[j][0] * y[j][0] + y[j][1] * y[j][1]) + (y[j][2] * y[j][2] + y[j][3] * y[j][3]); }
            const float rstd = rsqrtf(wave_sum(ss) * (1.0f / DM) + EPS);
#pragma unroll
            for (int j = 0; j < 8; ++j) *(f32x4*)(orow + 4 * F.lane + 256 * j) = v[j] + g2[j] * (y[j] * rstd);
        }
    }
}

constexpr int NPH = 11;
struct Args { const void* in[18]; float* out; unsigned char* ws; int ph_lo, ph_hi; };
__global__ void __launch_bounds__(NWAVES * 64, 2) fwd_kernel(Args args) {
    extern __shared__ __attribute__((aligned(16))) unsigned char lds_raw[];
    Frame F;
    F.lds = (LAS unsigned char*)lds_raw;
    F.tid = threadIdx.x; F.lane = F.tid & 63; F.wave = __builtin_amdgcn_readfirstlane(F.tid >> 6);
    F.G = gridDim.x; { const int bx = blockIdx.x; F.vcu = (F.G % 8 == 0) ? (bx % 8) * (F.G / 8) + bx / 8 : bx; }
    F.x = (const float*)args.in[0]; F.c = (const float*)args.in[1]; F.positions = (const int*)args.in[2]; F.w_ada = (const float*)args.in[3]; F.b_ada = (const float*)args.in[4];
    F.g_pre_mix = (const float*)args.in[5]; F.g_post_mix = (const float*)args.in[6]; F.g_pre_ffn = (const float*)args.in[7]; F.g_post_ffn = (const float*)args.in[8];
    F.w_in = (const float*)args.in[9]; F.sinks = (const float*)args.in[10]; F.w_ap = (const float*)args.in[11]; F.hg_lb = (const float*)args.in[12]; F.hg_norm = (const float*)args.in[13];
    F.w_hp = (const float*)args.in[14]; F.w_out = (const float*)args.in[15]; F.w_fi = (const float*)args.in[16]; F.w_fo = (const float*)args.in[17];
    F.out = args.out; F.ws = args.ws;
    volatile LAS unsigned* MISC = (volatile LAS unsigned*)(F.lds + MISC_OFF);
    for (int u = F.tid; u < (LDS_BYTES - LDSCTL_OFF) / 4; u += NWAVES * 64) ((LAS unsigned*)(F.lds + LDSCTL_OFF))[u] = 0u;
    __syncthreads();
    const int lo = args.ph_lo, hi = args.ph_hi;
    XcdBarrier bar; bar.bar = WSP(unsigned, WS_CTL) + CW_BAR; bar.x = 0; bar.st = nullptr;
    if (hi - lo > 1) bar = xcd_barrier_post(WSP(unsigned, WS_CTL) + CW_BAR, MISC + 8);
#define IN(k) (lo <= (k) && (k) < hi)
#define SEAM(k) do { if (IN(k) && IN((k) + 1)) xcd_barrier(bar); } while (0)

    if (IN(0)) { p0_prologue(F); SEAM(0); }
    if (IN(1)) { p1_rows(F); SEAM(1); }
    if (IN(2)) {
        pg8::SingleOrder S; S.so.init(MTOK, INC, F.G, (int)blockIdx.x); S.A = (const char*)F.out + OUT_XN; S.B = (const char*)(F.ws + WS_WIN); S.tstep = (size_t)256 * DM * 2;
        EpiG1 E{F.ws, WSP(float, WS_ROPE), WSP(float, WS_LB)};
        pg8::gemm_phase<EpiG1, pg8::SingleOrder, true, true>(F.lds, DM, S, E);
        SEAM(2);
    }
    if (IN(3)) { hgrn_naive_scan(F); attn_naive(F); SEAM(3); }
    if (IN(4)) { hgrn_naive_finish(F); SEAM(4); }
    if (IN(5)) {
        pg8::DualOrder S; S.so.init(MTOK, DM, F.G, (int)blockIdx.x); S.A0 = (const char*)(F.ws + WS_QA); S.B0 = (const char*)(F.ws + WS_WAP); S.A1 = (const char*)(F.ws + WS_QH); S.B1 = (const char*)(F.ws + WS_WHP); S.tstep = (size_t)256 * AW * 2;
        EpiMerge E{WSP(bf16_t, WS_GA), WSP(bf16_t, WS_GHT), WSP(bf16_t, WS_MERGED)};
        pg8::gemm_phase<EpiMerge, pg8::DualOrder, true, true>(F.lds, AW, S, E);
        SEAM(5);
    }
    if (IN(6)) {
        pg8::SingleOrder S; S.so.init(MTOK, DM, F.G, (int)blockIdx.x); S.A = (const char*)(F.ws + WS_MERGED); S.B = (const char*)(F.ws + WS_WOUT); S.tstep = (size_t)256 * DM * 2;
        EpiPlain E{WSP(bf16_t, WS_Y), DM};
        pg8::gemm_phase<EpiPlain, pg8::SingleOrder, true, true>(F.lds, DM, S, E);
        SEAM(6);
    }
    if (IN(7)) { rows2(F); SEAM(7); }
    if (IN(8)) {
        pg8::SingleOrder S; S.so.init(MTOK, 2 * FFH, F.G, (int)blockIdx.x); S.A = (const char*)(F.ws + WS_H2); S.B = (const char*)(F.ws + WS_WFI); S.tstep = (size_t)256 * DM * 2;
        EpiSwiGLU E{WSP(bf16_t, WS_ACT)};
        pg8::gemm_phase<EpiSwiGLU, pg8::SingleOrder, true, true>(F.lds, DM, S, E);
        SEAM(8);
    }
    if (IN(9)) {
        pg8::SingleOrder S; S.so.init(MTOK, DM, F.G, (int)blockIdx.x); S.A = (const char*)(F.ws + WS_ACT); S.B = (const char*)(F.ws + WS_WFO); S.tstep = (size_t)256 * FFH * 2;
        EpiPlain E{WSP(bf16_t, WS_Y2), DM};
        pg8::gemm_phase<EpiPlain, pg8::SingleOrder, true, true>(F.lds, FFH, S, E);
        SEAM(9);
    }
    if (IN(10)) { rows3(F); }
#undef IN
#undef SEAM
}

extern "C" void kernel_launch(void* const* d_in, const int* in_sizes, int n_in, void* d_out, int out_size, void* d_ws, size_t ws_size, hipStream_t stream) {
    static int grid = 0;
    if (grid == 0) {
        if (n_in != 18 || in_sizes[0] != MTOK * DM || out_size != MTOK * DM || ws_size < WS_END) { fprintf(stderr, "kernel_launch: unexpected shapes (n_in %d, out %d, ws %zu); nothing launched\n", n_in, out_size, ws_size); grid = -1; return; }
        int dev = 0, cus = 0, per_cu = 0;
        if (hipGetDevice(&dev) != hipSuccess || hipDeviceGetAttribute(&cus, hipDeviceAttributeMultiprocessorCount, dev) != hipSuccess) { grid = -1; return; }
        if (hipFuncSetAttribute((const void*)fwd_kernel, hipFuncAttributeMaxDynamicSharedMemorySize, LDS_BYTES) != hipSuccess) { fprintf(stderr, "kernel_launch: hipFuncSetAttribute failed\n"); grid = -1; return; }
        if (hipOccupancyMaxActiveBlocksPerMultiprocessor(&per_cu, (const void*)fwd_kernel, NWAVES * 64, LDS_BYTES) != hipSuccess || per_cu < 1) { fprintf(stderr, "kernel_launch: occupancy query says %d blocks per CU\n", per_cu); (void)hipGetLastError(); grid = -1; return; }
        grid = cus;
    }
    if (grid < 0) return;
    (void)hipMemsetAsync((char*)d_ws + WS_CTL, 0, CTL_ZERO_BYTES, stream);
    Args a{};
    for (int i = 0; i < 18; ++i) a.in[i] = d_in[i];
    a.out = (float*)d_out; a.ws = (unsigned char*)d_ws;
    if (MK_N_LAUNCHES == 1) { a.ph_lo = 0; a.ph_hi = NPH; hipLaunchKernelGGL(fwd_kernel, dim3(grid), dim3(NWAVES * 64), LDS_BYTES, stream, a); }
    else for (int p = 0; p < NPH; ++p) { a.ph_lo = p; a.ph_hi = p + 1; hipLaunchKernelGGL(fwd_kernel, dim3(grid), dim3(NWAVES * 64), LDS_BYTES, stream, a); }
}
```

```cpp
#include <hip/hip_runtime.h>
#include <cstdio>
#include <cstdint>

#ifndef MK_N_LAUNCHES
#define MK_N_LAUNCHES 1
#endif

#ifndef NAIVE_ATTN
#define NAIVE_ATTN 0
#endif
#ifndef NAIVE_HGRN
#define NAIVE_HGRN 0
#endif

#define LAS __attribute__((address_space(3)))
#define GAS __attribute__((address_space(1)))
typedef unsigned short bf16_t;
typedef short bf16x8 __attribute__((ext_vector_type(8)));
typedef float f32x4 __attribute__((ext_vector_type(4)));
typedef float f32x2 __attribute__((ext_vector_type(2)));
typedef unsigned u32x4 __attribute__((ext_vector_type(4)));
typedef unsigned u32x2 __attribute__((ext_vector_type(2)));
typedef float f32x16 __attribute__((ext_vector_type(16)));
typedef short v4i16_t __attribute__((ext_vector_type(4)));

constexpr int NWAVES = 8;
constexpr int NB = 8, SEQ = 2048, DM = 2048, MTOK = NB * SEQ;
constexpr int AW = 1024, KVW = 128, HGW = 1024, FFH = 5632, INC = 9472, NMODC = 6 * DM;
constexpr float EPS = 1e-6f;
constexpr float LOG2E = 1.4426950408889634f;
constexpr float QSCALE = 0.125f * 1.4426950408889634f;

typedef __bf16 bf16x2_t __attribute__((ext_vector_type(2)));
__device__ __forceinline__ unsigned cvt_pk_bf16(float lo, float hi) { const f32x2 v = {lo, hi}; const bf16x2_t b = __builtin_convertvector(v, bf16x2_t); return __builtin_bit_cast(unsigned, b); }
__device__ __forceinline__ float bflo(unsigned w) { return __uint_as_float(w << 16); }
__device__ __forceinline__ float bfhi(unsigned w) { return __uint_as_float(w & 0xffff0000u); }
__device__ __forceinline__ float bf2f(bf16_t h) { return __uint_as_float((unsigned)h << 16); }
__device__ __forceinline__ float fsigmoid(float x) { return 1.0f / (1.0f + __expf(-x)); }
__device__ __forceinline__ u32x4 pack8(f32x4 a, f32x4 b) { u32x4 w; w.x = cvt_pk_bf16(a[0], a[1]); w.y = cvt_pk_bf16(a[2], a[3]); w.z = cvt_pk_bf16(b[0], b[1]); w.w = cvt_pk_bf16(b[2], b[3]); return w; }
__device__ __forceinline__ void unpack8(u32x4 w, f32x4& a, f32x4& b) { a = (f32x4){bflo(w.x), bfhi(w.x), bflo(w.y), bfhi(w.y)}; b = (f32x4){bflo(w.z), bfhi(w.z), bflo(w.w), bfhi(w.w)}; }

namespace pg8 {
constexpr int BM = 256, BK = 64, HALF = 128, HTB = HALF * BK * 2  , STAGE_BYTES = 8 * HTB, NXCD = 8, WGM = 8;

__host__ __device__ __forceinline__ int lds_byte(int r, int c) { const int st = (r >> 4) * 2 + (c >> 5), rr = r & 15, cc = c & 31, ob = rr * 64 + cc * 2; return st * 1024 + (ob ^ (((ob >> 9) & 1) << 5)); }
__host__ __device__ __forceinline__ void stage_rc(int b, int& R, int& C) { const int st = b / 1024, sb = b % 1024, swz = sb ^ (((sb >> 9) & 1) << 5); R = (st >> 1) * 16 + swz / 64; C = (st & 1) * 32 + (swz % 64) / 2; }
__host__ __device__ __forceinline__ int perm32(int rho) { const int n = rho >> 4, i = rho & 15; return 8 * (i >> 2) + 4 * n + (i & 3); }

struct Unit { int pm, pn, sub; };

struct StaticOrder {
    int nM, nN, nwg, G, c;
    __host__ __device__ void init(int M, int N, int G_, int c_) { nM = M / BM; nN = N / BM; nwg = nM * nN; G = G_; c = c_; }
    __host__ __device__ bool next(int i, Unit& u) const {
        const long L = (long)i * G + c; if (L >= nwg) return false;
        int wgid = (int)L; { const int q = nwg / NXCD, r = nwg % NXCD, xcd = wgid % NXCD, off = wgid / NXCD; wgid = (xcd < r ? xcd * (q + 1) : r * (q + 1) + (xcd - r) * q) + off; }
        const int nig = WGM * nN, gid = wgid / nig, fm = gid * WGM, gsz = (nM - fm) < WGM ? (nM - fm) : WGM;
        u.pm = fm + ((wgid % nig) % gsz); u.pn = (wgid % nig) / gsz; u.sub = 0; return true;
    }
};
struct SingleOrder {
    StaticOrder so; const char* A; const char* B; size_t tstep;
    __device__ __forceinline__ bool next(int i, Unit& u) const { return so.next(i, u); }
    __device__ __forceinline__ const char* aptr(const Unit& u) const { return A + (size_t)u.pm * tstep; }
    __device__ __forceinline__ const char* bptr(const Unit& u) const { return B + (size_t)u.pn * tstep; }
};
struct DualOrder {
    StaticOrder so; const char *A0, *B0, *A1, *B1; size_t tstep;
    __device__ __forceinline__ bool next(int i, Unit& u) const { if (!so.next(i >> 1, u)) return false; u.sub = i & 1; return true; }
    __device__ __forceinline__ const char* aptr(const Unit& u) const { return (u.sub ? A1 : A0) + (size_t)u.pm * tstep; }
    __device__ __forceinline__ const char* bptr(const Unit& u) const { return (u.sub ? B1 : B0) + (size_t)u.pn * tstep; }
};

typedef f32x4 Acc[2][2][4][2];

template <class Epi, class Sched, bool ALIGN_EPI, bool SP2>
__device__ __forceinline__ void gemm_phase(LAS unsigned char* lds, const int K, const Sched& S, const Epi& E) {
    const int tid = threadIdx.x, wid = __builtin_amdgcn_readfirstlane(tid >> 6), lane = tid & 63, wr = wid >> 2, wc = wid & 3, fr = lane & 15, fq = lane >> 4;
    const int nt = K / BK;
    unsigned voffA[2], voffB[2];
#pragma unroll
    for (int i = 0; i < 2; ++i) { int R, C; stage_rc(tid * 16 + i * 8192, R, C); const int Rb = ((R & ~31) + perm32(R & 31));
        voffA[i] = (unsigned)(R * K + C) * 2u; voffB[i] = (unsigned)(Rb * K + C) * 2u; }
    const size_t kstep = (size_t)(BK * 2);
    const size_t hstep = (size_t)HALF * K * 2;
    const unsigned ldsw = (unsigned)wid * 1024u;
    const int aoff = lds_byte(wr * 64 + fr, fq * 8), boff = lds_byte(wc * 32 + fr, fq * 8);
#define PG8_SA(b, h) (((b) * 2 + (h)) * HTB)
#define PG8_SB(b, h) ((4 + (b) * 2 + (h)) * HTB)
#define PG8_STAGE(bufoff, gbase, voff) do { _Pragma("unroll") for (int _i = 0; _i < 2; ++_i) \
        __builtin_amdgcn_global_load_lds((const unsigned*)((const char*)(gbase) + (voff)[_i]), (LAS unsigned*)(lds + (bufoff) + ldsw + _i * 8192), 16, 0, 0); } while (0)
#define PG8_LDA(dst, b, h) do { _Pragma("unroll") for (int m = 0; m < 4; ++m) _Pragma("unroll") for (int k = 0; k < 2; ++k) dst[m][k] = *(const LAS bf16x8*)(lds + PG8_SA(b, h) + aoff + m * 2048 + k * 1024); } while (0)
#define PG8_LDB(dst, b, h) do { _Pragma("unroll") for (int n = 0; n < 2; ++n) _Pragma("unroll") for (int k = 0; k < 2; ++k) dst[n][k] = *(const LAS bf16x8*)(lds + PG8_SB(b, h) + boff + n * 2048 + k * 1024); } while (0)
#define PG8_MMA(ai, bj, At, Bt) do { __builtin_amdgcn_s_setprio(1); _Pragma("unroll") for (int m = 0; m < 4; ++m) _Pragma("unroll") for (int n = 0; n < 2; ++n) _Pragma("unroll") for (int k = 0; k < 2; ++k) \
        acc[ai][bj][m][n] = __builtin_amdgcn_mfma_f32_16x16x32_bf16(Bt[n][k], At[m][k], acc[ai][bj][m][n], 0, 0, 0); __builtin_amdgcn_s_setprio(0); } while (0)
#define PG8_WAIT_V(n) asm volatile("s_waitcnt vmcnt(" #n ")" ::: "memory")
#define PG8_WAIT_L(n) asm volatile("s_waitcnt lgkmcnt(" #n ")" ::: "memory")
#define PG8_BAR __builtin_amdgcn_s_barrier()
#define PG8_SCHED __builtin_amdgcn_sched_barrier(0)
    Unit cur, nxt; int ui = 0;
    if (!S.next(0, cur)) return;
    Acc acc;
#pragma unroll
    for (int a = 0; a < 2; ++a)
#pragma unroll
        for (int b = 0; b < 2; ++b)
#pragma unroll
            for (int m = 0; m < 4; ++m)
#pragma unroll
                for (int n = 0; n < 2; ++n) acc[a][b][m][n] = (f32x4){0.f, 0.f, 0.f, 0.f};
    bf16x8 At[4][2], B0[2][2], B1[2][2];
    const char* cA = S.aptr(cur); const char* cB = S.bptr(cur);
    if constexpr (SP2) {
        PG8_STAGE(PG8_SB(0, 0), cB, voffB); PG8_STAGE(PG8_SB(0, 1), cB + hstep, voffB); PG8_STAGE(PG8_SA(0, 0), cA, voffA); PG8_STAGE(PG8_SA(0, 1), cA + hstep, voffA);
        if (wr == 1) PG8_BAR;
        PG8_WAIT_V(2); PG8_BAR;
        PG8_STAGE(PG8_SB(1, 0), cB + kstep, voffB); PG8_STAGE(PG8_SA(1, 0), cA + kstep, voffA); PG8_STAGE(PG8_SB(1, 1), cB + hstep + kstep, voffB);
        PG8_WAIT_V(6); PG8_BAR;
    } else {
        PG8_STAGE(PG8_SB(0, 0), cB, voffB); PG8_STAGE(PG8_SA(0, 0), cA, voffA); PG8_STAGE(PG8_SB(0, 1), cB + hstep, voffB); PG8_STAGE(PG8_SA(0, 1), cA + hstep, voffA);
        if (wr == 1) PG8_BAR;
        PG8_WAIT_V(4); PG8_BAR;
        PG8_STAGE(PG8_SB(1, 0), cB + kstep, voffB); PG8_STAGE(PG8_SA(1, 0), cA + kstep, voffA); PG8_STAGE(PG8_SB(1, 1), cB + hstep + kstep, voffB);
        PG8_WAIT_V(6); PG8_BAR;
    }
    for (;;) {
        const bool has_next = S.next(ui + 1, nxt);
        const char* nA = has_next ? S.aptr(nxt) : cA; const char* nB = has_next ? S.bptr(nxt) : cB;
        for (int t = 0; t < nt; t += 2) {
            const bool last = (t == nt - 2);
            const char* a1 = cA + (size_t)(t + 1) * kstep;
            const char* a2 = last ? nA : cA + (size_t)(t + 2) * kstep; const char* b2 = last ? nB : cB + (size_t)(t + 2) * kstep;
            const char* a3 = a2 + kstep; const char* b3 = b2 + kstep;
            if constexpr (SP2) {
            PG8_LDB(B0, 0, 0); PG8_LDB(B1, 0, 1); PG8_SCHED; PG8_LDA(At, 0, 0); PG8_STAGE(PG8_SA(1, 1), a1 + hstep, voffA);
            PG8_WAIT_V(8); PG8_WAIT_L(0); PG8_BAR; PG8_MMA(0, 0, At, B0); PG8_MMA(0, 1, At, B1); PG8_BAR; PG8_SCHED;
            PG8_LDA(At, 0, 1); PG8_STAGE(PG8_SB(0, 0), b2, voffB); PG8_STAGE(PG8_SB(0, 1), b2 + hstep, voffB); PG8_STAGE(PG8_SA(0, 0), a2, voffA);
            PG8_WAIT_V(8); PG8_WAIT_L(0); PG8_BAR; PG8_MMA(1, 0, At, B0); PG8_MMA(1, 1, At, B1); PG8_BAR; PG8_SCHED;
            PG8_LDB(B0, 1, 0); PG8_LDB(B1, 1, 1); PG8_SCHED; PG8_LDA(At, 1, 0); PG8_STAGE(PG8_SA(0, 1), a2 + hstep, voffA);
            PG8_WAIT_V(8); PG8_WAIT_L(0); PG8_BAR; PG8_MMA(0, 0, At, B0); PG8_MMA(0, 1, At, B1); PG8_BAR; PG8_SCHED;
            PG8_LDA(At, 1, 1); PG8_STAGE(PG8_SB(1, 0), b3, voffB); PG8_STAGE(PG8_SB(1, 1), b3 + hstep, voffB); PG8_STAGE(PG8_SA(1, 0), a3, voffA);
            PG8_WAIT_V(8); PG8_WAIT_L(0); PG8_BAR; PG8_MMA(1, 0, At, B0); PG8_MMA(1, 1, At, B1); PG8_BAR; PG8_SCHED;
            } else {
            PG8_LDB(B0, 0, 0); PG8_SCHED; PG8_LDA(At, 0, 0); PG8_STAGE(PG8_SA(1, 1), a1 + hstep, voffA);
            PG8_WAIT_L(8); PG8_BAR; PG8_WAIT_L(0); PG8_MMA(0, 0, At, B0); PG8_BAR; PG8_SCHED;
            PG8_LDB(B1, 0, 1); PG8_STAGE(PG8_SB(0, 0), b2, voffB);
            PG8_BAR; PG8_WAIT_L(0); PG8_MMA(0, 1, At, B1); PG8_BAR;
            PG8_LDA(At, 0, 1); PG8_STAGE(PG8_SA(0, 0), a2, voffA);
            PG8_BAR; PG8_WAIT_L(0); PG8_MMA(1, 0, At, B0); PG8_BAR; PG8_SCHED;
            PG8_STAGE(PG8_SB(0, 1), b2 + hstep, voffB);
            PG8_WAIT_V(6); PG8_BAR; PG8_MMA(1, 1, At, B1); PG8_BAR;
            PG8_LDB(B0, 1, 0); PG8_SCHED; PG8_LDA(At, 1, 0); PG8_STAGE(PG8_SA(0, 1), a2 + hstep, voffA);
            PG8_WAIT_L(8); PG8_BAR; PG8_WAIT_L(0); PG8_MMA(0, 0, At, B0); PG8_BAR; PG8_SCHED;
            PG8_LDB(B1, 1, 1); PG8_STAGE(PG8_SB(1, 0), b3, voffB);
            PG8_BAR; PG8_WAIT_L(0); PG8_MMA(0, 1, At, B1); PG8_BAR;
            PG8_LDA(At, 1, 1); PG8_STAGE(PG8_SA(1, 0), a3, voffA);
            PG8_BAR; PG8_WAIT_L(0); PG8_MMA(1, 0, At, B0); PG8_BAR; PG8_SCHED;
            PG8_STAGE(PG8_SB(1, 1), b3 + hstep, voffB);
            PG8_WAIT_V(6); PG8_BAR; PG8_MMA(1, 1, At, B1); PG8_BAR;
            }
        }
        if constexpr (ALIGN_EPI) { if (wr == 0) PG8_BAR; }
        E(acc, cur, wr, wc, fr, fq);
        if (!has_next) break;
        if (!Epi::keep_acc(cur)) {
#pragma unroll
        for (int a = 0; a < 2; ++a)
#pragma unroll
            for (int b = 0; b < 2; ++b)
#pragma unroll
                for (int m = 0; m < 4; ++m)
#pragma unroll
                    for (int n = 0; n < 2; ++n) acc[a][b][m][n] = (f32x4){0.f, 0.f, 0.f, 0.f};
        }
        cur = nxt; cA = nA; cB = nB; ++ui;
        if constexpr (ALIGN_EPI) { if (wr == 1) PG8_BAR; }
    }
    PG8_WAIT_V(0);
    if constexpr (!ALIGN_EPI) { if (wr == 0) PG8_BAR; }
    PG8_BAR;
#undef PG8_SA
#undef PG8_SB
#undef PG8_STAGE
#undef PG8_LDA
#undef PG8_LDB
#undef PG8_MMA
#undef PG8_WAIT_V
#undef PG8_WAIT_L
#undef PG8_BAR
#undef PG8_SCHED
}
}

constexpr size_t MiB = 1u << 20;
constexpr size_t WS_CTL = 0, CTL_ZERO_BYTES = 64 * 1024;
constexpr size_t WS_MOD = 1 * MiB;
constexpr size_t WS_LB = 1 * MiB + 512 * 1024;
constexpr size_t WS_ROPE = 2 * MiB;
constexpr size_t WS_DEC = 3 * MiB;
constexpr size_t WS_WIN = 4 * MiB, WS_WAP = 41 * MiB, WS_WHP = 45 * MiB, WS_WOUT = 49 * MiB, WS_WFI = 57 * MiB, WS_WFO = 101 * MiB;
constexpr size_t WS_QA = 128 * MiB, WS_QH = 160 * MiB, WS_KH = 192 * MiB, WS_LF = 224 * MiB, WS_IH = 256 * MiB, WS_GH = 288 * MiB;
constexpr size_t WS_KA = 320 * MiB, WS_VA = 324 * MiB, WS_GA = 328 * MiB, WS_GHT = 392 * MiB;
constexpr size_t WS_MERGED = 192 * MiB;
constexpr size_t WS_Y = 128 * MiB;
constexpr size_t WS_H2 = 256 * MiB;
constexpr size_t WS_ACT = 328 * MiB;
constexpr size_t WS_Y2 = 128 * MiB;
constexpr size_t WS_END = 504 * MiB;
constexpr size_t OUT_XN = 0, OUT_ORAW = 0, OUT_US = 64 * MiB, OUT_SS = 0;

constexpr int CW_BAR = 4096;

constexpr int RING_BYTES = 131072;
constexpr int LDSCTL_OFF = RING_BYTES, MISC_OFF = LDSCTL_OFF + 320;
constexpr int LDS_BYTES = 147456;

#define RLX_AGENT __ATOMIC_RELAXED, __HIP_MEMORY_SCOPE_AGENT
#define LDS_WAIT() asm volatile("s_waitcnt lgkmcnt(0)" ::: "memory")

#define XB_TMO      128
#define XB_XCNT(j)  (256  + 64 * (j))
#define XB_XSUB(j)  (1280 + 64 * (j))
#define XB_XGEN(j)  (2304 + 64 * (j))
#define XB_TOP      3328
#define XB_TOPGEN   3392
#define XCD_BAR_WORDS 3456
#define XB_SPIN_CAP (1u << 22)

__device__ __forceinline__ unsigned xb_ld(unsigned* p)              { return __hip_atomic_load(p, __ATOMIC_RELAXED, __HIP_MEMORY_SCOPE_AGENT); }
__device__ __forceinline__ unsigned xb_add(unsigned* p, unsigned v) { return __hip_atomic_fetch_add(p, v, __ATOMIC_RELAXED, __HIP_MEMORY_SCOPE_AGENT); }
__device__ __forceinline__ unsigned xb_xcc_id() { return (unsigned)__builtin_amdgcn_s_getreg((3 << 11) | 20) & 0xFu; }
#define XB_SPIN(cond, bar) do { unsigned _sp = 0; while (cond) { __builtin_amdgcn_s_sleep(1); \
    if ((++_sp & 255u) == 0u) { if (xb_ld(&(bar)[XB_TMO])) break; if (_sp > XB_SPIN_CAP) { atomicAdd(&(bar)[XB_TMO], 1u); break; } } } } while (0)

struct XcdBarrier { unsigned* bar; unsigned x; volatile LAS unsigned* st; };

__device__ __forceinline__ XcdBarrier xcd_barrier_post(unsigned* bar, volatile LAS unsigned* st) {
    XcdBarrier b; b.bar = bar; b.x = xb_xcc_id(); b.st = st;
    if (threadIdx.x == 0) (void)xb_add(&bar[XB_XCNT(b.x)], 1u);
    return b;
}
__device__ __forceinline__ void xcd_barrier_complete(unsigned* bar, unsigned x, unsigned& nloc, unsigned& nx) {
    const unsigned G = gridDim.x * gridDim.y * gridDim.z;
    unsigned sum, cnt, mine, sp = 0u;
    for (;;) {
        sum = 0u; cnt = 0u; mine = 0u;
#pragma unroll
        for (unsigned j = 0; j < 16; ++j) { const unsigned c = xb_ld(&bar[XB_XCNT(j)]); sum += c; cnt += (c > 0u) ? 1u : 0u; mine = (j == x) ? c : mine; }
        if (sum == G) break;
        __builtin_amdgcn_s_sleep(1);
        if ((++sp & 255u) == 0u) { if (xb_ld(&bar[XB_TMO])) break; if (sp > XB_SPIN_CAP) { atomicAdd(&bar[XB_TMO], 1u); break; } }
    }
    nloc = mine > 0u ? mine : 1u; nx = cnt > 0u ? cnt : 1u;
}
__device__ __forceinline__ void xcd_barrier(const XcdBarrier& b) {
    asm volatile("s_waitcnt vmcnt(0)" ::: "memory");
    __syncthreads();
    if (threadIdx.x == 0) {
        unsigned* bar = b.bar;
        __builtin_amdgcn_s_waitcnt(0);
        unsigned nloc = b.st[0], nx = b.st[1];
        if (nloc == 0u) { xcd_barrier_complete(bar, b.x, nloc, nx); b.st[0] = nloc; b.st[1] = nx; }
        const unsigned old = xb_add(&bar[XB_XSUB(b.x)], 1u);
        const unsigned gen = old / nloc;
        if (old + 1u == (gen + 1u) * nloc) {
            __builtin_amdgcn_fence(__ATOMIC_RELEASE, "agent");
            asm volatile("s_waitcnt vmcnt(0)" ::: "memory");
            const unsigned og = xb_add(&bar[XB_TOP], 1u);
            const unsigned tg = og / nx;
            if (og + 1u == (tg + 1u) * nx) xb_add(&bar[XB_TOPGEN], 1u);
            else XB_SPIN(xb_ld(&bar[XB_TOPGEN]) == tg, bar);
            __builtin_amdgcn_fence(__ATOMIC_ACQUIRE, "agent");
            xb_add(&bar[XB_XGEN(b.x)], 1u);
            asm volatile("s_waitcnt vmcnt(0)" ::: "memory");
        } else {
            XB_SPIN(xb_ld(&bar[XB_XGEN(b.x)]) == gen, bar);
            __builtin_amdgcn_fence(__ATOMIC_ACQUIRE, "agent");
            asm volatile("s_waitcnt vmcnt(0)" ::: "memory");
        }
    }
    __syncthreads();
}

struct Frame {
    LAS unsigned char* lds;
    int tid, lane, wave, vcu, G;
    const float *x, *c, *w_ada, *b_ada, *g_pre_mix, *g_post_mix, *g_pre_ffn, *g_post_ffn, *w_in, *sinks, *w_ap, *hg_lb, *hg_norm, *w_hp, *w_out, *w_fi, *w_fo;
    const int* positions;
    float* out;
    unsigned char* ws;
};
#define WSP(T, off) ((T*)(F.ws + (off)))

__device__ __forceinline__ float wave_sum(float v) {
#pragma unroll
    for (int o = 1; o < 64; o <<= 1) v += __shfl_xor(v, o);
    return v;
}

__device__ __forceinline__ int win_dst(int n) {
    if (n < AW + KVW) { int p = n & 63; if (p >= 4 && p < 12) p = (p < 8) ? p + 4 : p - 4; return (n & ~63) + p; }
    return n;
}
__device__ __forceinline__ int wfi_dst(int n) {
    if (n < FFH) return 256 * (n >> 7) + (n & 127);
    n -= FFH; return 256 * (n >> 7) + 128 + (n & 127);
}
__device__ __forceinline__ unsigned f2bf(float f) { unsigned u = __builtin_bit_cast(unsigned, f); return (u + 0x7fffu + ((u >> 16) & 1u)) >> 16; }
__device__ __forceinline__ unsigned pk2(float lo, float hi) { return f2bf(lo) | (f2bf(hi) << 16); }
template <int MODE>
__device__ __forceinline__ void p0_transpose_item(const float* W, int K, int N, bf16_t* WT, LAS float* scr, int item, int lane) {
    const int nblk = N / 32, kb = item / nblk, nb = item % nblk, k0 = 64 * kb, n0 = 32 * nb;
#pragma unroll 8
    for (int i = 0; i < 32; ++i) { const int kk = 2 * i + (lane >> 5); scr[kk * 33 + (lane & 31)] = W[(size_t)(k0 + kk) * N + n0 + (lane & 31)]; }
    LDS_WAIT(); asm volatile("" ::: "memory");
    const int c = lane & 7;
#pragma unroll
    for (int j = 0; j < 4; ++j) { const int n = (lane >> 3) + 8 * j; const LAS float* s = scr + (8 * c) * 33 + n;
        u32x4 o; o.x = pk2(s[0 * 33], s[1 * 33]); o.y = pk2(s[2 * 33], s[3 * 33]); o.z = pk2(s[4 * 33], s[5 * 33]); o.w = pk2(s[6 * 33], s[7 * 33]);
        const int nn = n0 + n; const int row = (MODE == 1) ? win_dst(nn) : (MODE == 2) ? wfi_dst(nn) : nn;
        *(u32x4*)(WT + (size_t)row * K + k0 + 8 * c) = o; }
    LDS_WAIT(); asm volatile("" ::: "memory");
}
__device__ __forceinline__ void p0_convert_item(Frame& F, LAS float* scr, int it) {
    constexpr int I_IN = (DM / 64) * (INC / 32), I_AP = (AW / 64) * (DM / 32), I_HP = (HGW / 64) * (DM / 32), I_OUT = (DM / 64) * (DM / 32), I_FI = (DM / 64) * (2 * FFH / 32);
    int r = it;
    if (r < I_IN) { p0_transpose_item<1>(F.w_in, DM, INC, WSP(bf16_t, WS_WIN), scr, r, F.lane); return; } r -= I_IN;
    if (r < I_AP) { p0_transpose_item<0>(F.w_ap, AW, DM, WSP(bf16_t, WS_WAP), scr, r, F.lane); return; } r -= I_AP;
    if (r < I_HP) { p0_transpose_item<0>(F.w_hp, HGW, DM, WSP(bf16_t, WS_WHP), scr, r, F.lane); return; } r -= I_HP;
    if (r < I_OUT) { p0_transpose_item<0>(F.w_out, DM, DM, WSP(bf16_t, WS_WOUT), scr, r, F.lane); return; } r -= I_OUT;
    if (r < I_FI) { p0_transpose_item<2>(F.w_fi, DM, 2 * FFH, WSP(bf16_t, WS_WFI), scr, r, F.lane); return; } r -= I_FI;
    p0_transpose_item<0>(F.w_fo, FFH, DM, WSP(bf16_t, WS_WFO), scr, r, F.lane);
}
constexpr int N_CONV_ITEMS = (DM / 64) * (INC / 32) + 2 * (AW / 64) * (DM / 32) + (DM / 64) * (DM / 32) + (DM / 64) * (2 * FFH / 32) + (FFH / 64) * (DM / 32);
constexpr int N_MOD_ITEMS = NMODC / 64;

__device__ __forceinline__ double rope_rev(int f) {
    switch (f) { case 0: return 0.15915494309189535; case 1: return 0.03086376340470123; case 2: return 0.005985185712713705; case 3: return 0.001160663641240061;
                 case 4: return 0.00022507907903927653; case 5: return 4.364795279280289e-05; case 6: return 8.464330808241401e-06; default: return 1.6414262627950345e-06; }
}

__device__ __forceinline__ void p0_prologue(Frame& F) {
    for (int idx = blockIdx.x * 512 + F.tid; idx < MTOK * 8; idx += F.G * 512) {
        const int m = idx >> 3, f = idx & 7;
        const double rev = (double)F.positions[m] * rope_rev(f);
        const float fr = (float)(rev - floor(rev));
        float* rp = WSP(float, WS_ROPE) + (size_t)m * 16;
        rp[f] = __builtin_amdgcn_cosf(fr); rp[8 + f] = __builtin_amdgcn_sinf(fr);
        if (idx < HGW) { const float a0 = F.hg_lb[idx], a1 = F.hg_lb[HGW + idx]; WSP(float, WS_LB)[idx] = 1.0f / (1.0f + __expf(a1 - a0)); }
    }
    if ((int)blockIdx.x < N_MOD_ITEMS) {
        const int item = blockIdx.x;
        LAS float* cT = (LAS float*)F.lds + F.wave * 2048;
        LAS float* red = (LAS float*)(F.lds + 65536);
        const int k0 = F.wave * 256;
#pragma unroll 4
        for (int i = 0; i < 32; ++i) { const int idx = i * 64 + F.lane; cT[idx] = F.c[(idx & 7) * DM + k0 + (idx >> 3)]; }
        LDS_WAIT(); asm volatile("" ::: "memory");
        float acc[8];
#pragma unroll
        for (int b = 0; b < 8; ++b) acc[b] = 0.f;
        const float* wp = F.w_ada + (size_t)k0 * NMODC + item * 64 + F.lane;
#pragma unroll 16
        for (int k = 0; k < 256; ++k) {
            const float w = wp[(size_t)k * NMODC];
            const f32x4 c0 = *(const LAS f32x4*)(cT + k * 8), c1 = *(const LAS f32x4*)(cT + k * 8 + 4);
            acc[0] += w * c0[0]; acc[1] += w * c0[1]; acc[2] += w * c0[2]; acc[3] += w * c0[3];
            acc[4] += w * c1[0]; acc[5] += w * c1[1]; acc[6] += w * c1[2]; acc[7] += w * c1[3];
        }
#pragma unroll
        for (int b = 0; b < 8; ++b) red[(F.wave * 8 + b) * 64 + F.lane] = acc[b];
        __syncthreads();
        float s = F.b_ada[item * 64 + F.lane];
#pragma unroll
        for (int w = 0; w < 8; ++w) s += red[(w * 8 + F.wave) * 64 + F.lane];
        WSP(float, WS_MOD)[F.wave * NMODC + item * 64 + F.lane] = s;
        __syncthreads();
    }
    LAS float* scr = (LAS float*)(F.lds + F.wave * 16384);
    if ((int)blockIdx.x >= N_MOD_ITEMS) {
        const int base = ((int)blockIdx.x - N_MOD_ITEMS) * 64 + F.wave * 8;
        for (int j = 0; j < 8; ++j) p0_convert_item(F, scr, base + j);
    }
    const int first = ((int)F.G > N_MOD_ITEMS) ? ((int)F.G - N_MOD_ITEMS) * 64 : 0;
    for (int it = first + blockIdx.x * NWAVES + F.wave; it < N_CONV_ITEMS; it += F.G * NWAVES) p0_convert_item(F, scr, it);
}

__device__ __forceinline__ void p1_rows(Frame& F) {
    const int gw = blockIdx.x * NWAVES + F.wave, NGW = F.G * NWAVES;
    bf16_t* XN = (bf16_t*)((unsigned char*)F.out + OUT_XN);
    for (int r0 = gw * 8; r0 < MTOK; r0 += NGW * 8) {
        const int b = r0 / SEQ;
        const float* mod = WSP(float, WS_MOD) + (size_t)b * NMODC;
        f32x4 ga[8], sh[8];
#pragma unroll
        for (int j = 0; j < 8; ++j) { const int col = 4 * F.lane + 256 * j;
            const f32x4 g = *(const f32x4*)(F.g_pre_mix + col), sc = *(const f32x4*)(mod + DM + col); sh[j] = *(const f32x4*)(mod + col); ga[j] = g * (1.0f + sc); }
        for (int r = r0; r < r0 + 8; ++r) {
            const float* xr = F.x + (size_t)r * DM;
            f32x4 v[8]; float ss = 0.f;
#pragma unroll
            for (int j = 0; j < 8; ++j) { v[j] = *(const f32x4*)(xr + 4 * F.lane + 256 * j); ss += (v[j][0] * v[j][0] + v[j][1] * v[j][1]) + (v[j][2] * v[j][2] + v[j][3] * v[j][3]); }
            const float rstd = rsqrtf(wave_sum(ss) * (1.0f / DM) + EPS);
            bf16_t* orow = XN + (size_t)r * DM;
#pragma unroll
            for (int j = 0; j < 8; ++j) { const f32x4 h = v[j] * rstd * ga[j] + sh[j]; u32x2 w; w.x = cvt_pk_bf16(h[0], h[1]); w.y = cvt_pk_bf16(h[2], h[3]); *(u32x2*)(orow + 4 * F.lane + 256 * j) = w; }
        }
    }
}

struct EpiG1 {
    unsigned char* ws; const float* rope; const float* lbv;
    static __device__ __forceinline__ bool keep_acc(const pg8::Unit&) { return false; }
    __device__ __forceinline__ void operator()(pg8::Acc& acc, const pg8::Unit& u, int wr, int wc, int fr, int fq) const {
        const int pn = u.pn; const int row0 = u.pm * 256 + wr * 64 + fr; const int cl = wc * 32 + 8 * fq;
        if (pn <= 4) {
            const bool dorope = ((wc & 1) == 0) && (fq < 2);
#pragma unroll
            for (int ai = 0; ai < 2; ++ai)
#pragma unroll
                for (int m = 0; m < 4; ++m) { const int row = row0 + ai * 128 + m * 16;
                    f32x4 cs = (f32x4){1.f, 1.f, 1.f, 1.f}, sn = (f32x4){0.f, 0.f, 0.f, 0.f};
                    if (dorope) { const float* rp = rope + (size_t)row * 16 + 4 * fq; cs = *(const f32x4*)rp; sn = *(const f32x4*)(rp + 8); }
#pragma unroll
                    for (int bj = 0; bj < 2; ++bj) { f32x4 v0 = acc[ai][bj][m][0], v1 = acc[ai][bj][m][1];
                        const bool isv = (pn == 4 && bj == 1);
                        if (dorope && !isv) { const f32x4 n0 = v0 * cs - v1 * sn, n1 = v1 * cs + v0 * sn; v0 = n0; v1 = n1; }
                        bf16_t* dst;
                        if (pn < 4) { v0 = v0 * QSCALE; v1 = v1 * QSCALE; dst = (bf16_t*)(ws + WS_QA) + (size_t)row * AW + pn * 256 + bj * 128 + cl; }
                        else dst = (bf16_t*)(ws + (bj == 0 ? WS_KA : WS_VA)) + (size_t)row * KVW + cl;
                        *(u32x4*)dst = pack8(v0, v1); } }
        } else if (pn <= 8) {
#pragma unroll
            for (int ai = 0; ai < 2; ++ai)
#pragma unroll
                for (int m = 0; m < 4; ++m) { const int row = row0 + ai * 128 + m * 16;
#pragma unroll
                    for (int bj = 0; bj < 2; ++bj) { f32x4 v0 = acc[ai][bj][m][0], v1 = acc[ai][bj][m][1];
#pragma unroll
                        for (int e = 0; e < 4; ++e) { v0[e] = v0[e] * fsigmoid(v0[e]); v1[e] = v1[e] * fsigmoid(v1[e]); }
                        *(u32x4*)((bf16_t*)(ws + WS_QH) + (size_t)row * HGW + (pn - 5) * 256 + bj * 128 + cl) = pack8(v0, v1); } }
        } else if (pn <= 12) {
#pragma unroll
            for (int bj = 0; bj < 2; ++bj) { const int col = (pn - 9) * 256 + bj * 128 + cl;
                const f32x4 lb0 = *(const f32x4*)(lbv + col), lb1 = *(const f32x4*)(lbv + col + 4);
#pragma unroll
                for (int ai = 0; ai < 2; ++ai)
#pragma unroll
                    for (int m = 0; m < 4; ++m) { const int row = row0 + ai * 128 + m * 16;
                        const f32x4 x0 = acc[ai][bj][m][0], x1 = acc[ai][bj][m][1]; f32x4 k0, k1, l0, l1;
#pragma unroll
                        for (int e = 0; e < 4; ++e) {
                            { const float xx = fminf(fmaxf(x0[e], -30.f), 30.f), ex = __expf(-xx), sg = 1.0f / (1.0f + ex), om = 1.0f - lb0[e]; k0[e] = om * (ex * sg); l0[e] = __logf(lb0[e] + om * sg); }
                            { const float xx = fminf(fmaxf(x1[e], -30.f), 30.f), ex = __expf(-xx), sg = 1.0f / (1.0f + ex), om = 1.0f - lb1[e]; k1[e] = om * (ex * sg); l1[e] = __logf(lb1[e] + om * sg); } }
                        *(u32x4*)((bf16_t*)(ws + WS_KH) + (size_t)row * HGW + col) = pack8(k0, k1);
                        *(u32x4*)((bf16_t*)(ws + WS_LF) + (size_t)row * HGW + col) = pack8(l0, l1); } }
        } else {
            bf16_t* base; int ldc, colt;
            if (pn <= 16) { base = (bf16_t*)(ws + WS_IH); ldc = HGW; colt = (pn - 13) * 256; }
            else if (pn <= 20) { base = (bf16_t*)(ws + WS_GH); ldc = HGW; colt = (pn - 17) * 256; }
            else if (pn <= 28) { base = (bf16_t*)(ws + WS_GA); ldc = DM; colt = (pn - 21) * 256; }
            else { base = (bf16_t*)(ws + WS_GHT); ldc = DM; colt = (pn - 29) * 256; }
            const bool sig = pn > 16;
#pragma unroll
            for (int ai = 0; ai < 2; ++ai)
#pragma unroll
                for (int m = 0; m < 4; ++m) { const int row = row0 + ai * 128 + m * 16;
#pragma unroll
                    for (int bj = 0; bj < 2; ++bj) { f32x4 v0 = acc[ai][bj][m][0], v1 = acc[ai][bj][m][1];
                        if (sig) {
#pragma unroll
                            for (int e = 0; e < 4; ++e) { v0[e] = fsigmoid(v0[e]); v1[e] = fsigmoid(v1[e]); } }
                        *(u32x4*)(base + (size_t)row * ldc + colt + bj * 128 + cl) = pack8(v0, v1); } }
        }
    }
};
struct EpiMerge {
    const bf16_t* ga; const bf16_t* gh; bf16_t* out;
    static __device__ __forceinline__ bool keep_acc(const pg8::Unit& u) { return u.sub == 0; }
    __device__ __forceinline__ void operator()(pg8::Acc& acc, const pg8::Unit& u, int wr, int wc, int fr, int fq) const {
        const int row0 = u.pm * 256 + wr * 64 + fr; const int col0 = u.pn * 256 + wc * 32 + 8 * fq;
#pragma unroll
        for (int ai = 0; ai < 2; ++ai)
#pragma unroll
            for (int m = 0; m < 4; ++m) { const size_t ro = (size_t)(row0 + ai * 128 + m * 16) * DM + col0;
#pragma unroll
                for (int bj = 0; bj < 2; ++bj) { f32x4 h0, h1; unpack8(*(const u32x4*)(gh + ro + bj * 128), h0, h1);
                    if (u.sub == 0) { f32x4 a0, a1; unpack8(*(const u32x4*)(ga + ro + bj * 128), a0, a1);
#pragma unroll
                        for (int e = 0; e < 4; ++e) { acc[ai][bj][m][0][e] *= a0[e] / h0[e]; acc[ai][bj][m][1][e] *= a1[e] / h1[e]; }
                    } else *(u32x4*)(out + ro + bj * 128) = pack8(acc[ai][bj][m][0] * h0, acc[ai][bj][m][1] * h1); } }
    }
};
struct EpiPlain {
    bf16_t* out; int ldc;
    static __device__ __forceinline__ bool keep_acc(const pg8::Unit&) { return false; }
    __device__ __forceinline__ void operator()(pg8::Acc& acc, const pg8::Unit& u, int wr, int wc, int fr, int fq) const {
        const int row0 = u.pm * 256 + wr * 64 + fr; const int col0 = u.pn * 256 + wc * 32 + 8 * fq;
#pragma unroll
        for (int ai = 0; ai < 2; ++ai)
#pragma unroll
            for (int m = 0; m < 4; ++m) { bf16_t* rp = out + (size_t)(row0 + ai * 128 + m * 16) * ldc + col0;
#pragma unroll
                for (int bj = 0; bj < 2; ++bj) *(u32x4*)(rp + bj * 128) = pack8(acc[ai][bj][m][0], acc[ai][bj][m][1]); }
    }
};
struct EpiSwiGLU {
    bf16_t* out;
    static __device__ __forceinline__ bool keep_acc(const pg8::Unit&) { return false; }
    __device__ __forceinline__ void operator()(pg8::Acc& acc, const pg8::Unit& u, int wr, int wc, int fr, int fq) const {
        const int row0 = u.pm * 256 + wr * 64 + fr; const int col0 = u.pn * 128 + wc * 32 + 8 * fq;
#pragma unroll
        for (int ai = 0; ai < 2; ++ai)
#pragma unroll
            for (int m = 0; m < 4; ++m) { f32x4 v0, v1;
#pragma unroll
                for (int e = 0; e < 4; ++e) { const float g0 = acc[ai][0][m][0][e], g1 = acc[ai][0][m][1][e]; v0[e] = g0 * fsigmoid(g0) * acc[ai][1][m][0][e]; v1[e] = g1 * fsigmoid(g1) * acc[ai][1][m][1][e]; }
                *(u32x4*)(out + (size_t)(row0 + ai * 128 + m * 16) * FFH + col0) = pack8(v0, v1); }
    }
};

__device__ __forceinline__ void attn_naive(Frame& F) {
    bf16_t* QA = WSP(bf16_t, WS_QA); const bf16_t* KA = WSP(bf16_t, WS_KA); const bf16_t* VA = WSP(bf16_t, WS_VA);
    for (int it = blockIdx.x * 512 + F.tid; it < MTOK * 16; it += F.G * 512) {
        const int m = it >> 4, hq = it & 15, b = m >> 11, s = m & 2047, kvh = hq >> 3;
        float q[64], o[64];
        bf16_t* qp = QA + (size_t)m * AW + hq * 64;
#pragma unroll
        for (int c = 0; c < 8; ++c) { const u32x4 w = *(const u32x4*)(qp + 8 * c); f32x4 a, bb; unpack8(w, a, bb);
#pragma unroll
            for (int e = 0; e < 4; ++e) { q[8 * c + e] = a[e]; q[8 * c + 4 + e] = bb[e]; } }
#pragma unroll
        for (int d = 0; d < 64; ++d) o[d] = 0.f;
        float mrun = F.sinks[hq] * LOG2E, den = 1.f;
        const int j0 = s >= 127 ? s - 127 : 0;
        for (int j = j0; j <= s; ++j) {
            const bf16_t* kr = KA + (size_t)(b * SEQ + j) * KVW + kvh * 64; const bf16_t* vr = VA + (size_t)(b * SEQ + j) * KVW + kvh * 64;
            float l = 0.f;
#pragma unroll
            for (int c = 0; c < 8; ++c) { f32x4 a, bb; unpack8(*(const u32x4*)(kr + 8 * c), a, bb);
#pragma unroll
                for (int e = 0; e < 4; ++e) { l += q[8 * c + e] * a[e]; l += q[8 * c + 4 + e] * bb[e]; } }
            const float mn = fmaxf(mrun, l), sc = exp2f(mrun - mn), p = exp2f(l - mn);
            den = den * sc + p; mrun = mn;
#pragma unroll
            for (int c = 0; c < 8; ++c) { f32x4 a, bb; unpack8(*(const u32x4*)(vr + 8 * c), a, bb);
#pragma unroll
                for (int e = 0; e < 4; ++e) { o[8 * c + e] = o[8 * c + e] * sc + p * a[e]; o[8 * c + 4 + e] = o[8 * c + 4 + e] * sc + p * bb[e]; } }
        }
        const float inv = 1.0f / den;
#pragma unroll
        for (int c = 0; c < 8; ++c) { f32x4 a, bb;
#pragma unroll
            for (int e = 0; e < 4; ++e) { a[e] = o[8 * c + e] * inv; bb[e] = o[8 * c + 4 + e] * inv; }
            *(u32x4*)(qp + 8 * c) = pack8(a, bb); }
    }
}
__device__ __forceinline__ void hgrn_naive_scan(Frame& F) {
    if (F.wave != 0 || (int)blockIdx.x >= 128) return;
    const int item = blockIdx.x, bh = item >> 1, vh = item & 1, b = bh >> 3, h = bh & 7;
    const bf16_t* QH = WSP(bf16_t, WS_QH); const bf16_t* KH = WSP(bf16_t, WS_KH); const bf16_t* LF = WSP(bf16_t, WS_LF); const bf16_t* IH = WSP(bf16_t, WS_IH);
    float* ORAW = (float*)((unsigned char*)F.out + OUT_ORAW);
    float st[128];
#pragma unroll
    for (int k = 0; k < 128; ++k) st[k] = 0.f;
    for (int t = 0; t < SEQ; ++t) {
        const size_t ro = (size_t)(b * SEQ + t) * HGW + h * 128;
        const float v = bf2f(IH[ro + vh * 64 + F.lane]);
        float o = 0.f;
#pragma unroll
        for (int c = 0; c < 16; ++c) { f32x4 q0, q1, k0, k1, l0, l1;
            unpack8(*(const u32x4*)(QH + ro + 8 * c), q0, q1); unpack8(*(const u32x4*)(KH + ro + 8 * c), k0, k1); unpack8(*(const u32x4*)(LF + ro + 8 * c), l0, l1);
#pragma unroll
            for (int e = 0; e < 4; ++e) {
                { const float f = exp2f(l0[e] * LOG2E); st[8 * c + e] = f * st[8 * c + e] + k0[e] * v; o += st[8 * c + e] * q0[e]; }
                { const float f = exp2f(l1[e] * LOG2E); st[8 * c + 4 + e] = f * st[8 * c + 4 + e] + k1[e] * v; o += st[8 * c + 4 + e] * q1[e]; } } }
        ORAW[ro + vh * 64 + F.lane] = o;
    }
}
__device__ __forceinline__ void hgrn_naive_finish(Frame& F) {
    const float* ORAW = (const float*)((unsigned char*)F.out + OUT_ORAW);
    bf16_t* HO = WSP(bf16_t, WS_QH); const bf16_t* GH = WSP(bf16_t, WS_GH);
    const int gw = blockIdx.x * NWAVES + F.wave, NGW = F.G * NWAVES;
    for (int it = gw; it < MTOK * 8; it += NGW) {
        const size_t ro = (size_t)(it >> 3) * HGW + (it & 7) * 128 + 2 * F.lane;
        const f32x2 o = *(const f32x2*)(ORAW + ro);
        const float rstd = rsqrtf(wave_sum(o[0] * o[0] + o[1] * o[1]) * (1.0f / 128.0f) + EPS);
        const f32x2 g = *(const f32x2*)(F.hg_norm + 2 * F.lane);
        const unsigned gw2 = *(const unsigned*)(GH + ro);
        *(unsigned*)(HO + ro) = cvt_pk_bf16(o[0] * rstd * g[0] * bflo(gw2), o[1] * rstd * g[1] * bfhi(gw2));
    }
}

__device__ __forceinline__ f32x16 mfma32(bf16x8 a, bf16x8 b, f32x16 c) { return __builtin_amdgcn_mfma_f32_32x32x16_bf16(a, b, c, 0, 0, 0); }
__device__ __forceinline__ v4i16_t tr_read(LAS unsigned char* p) { return __builtin_amdgcn_ds_read_tr16_b64_v4i16((LAS v4i16_t*)p); }
__device__ __forceinline__ bf16x8 cat44(v4i16_t lo, v4i16_t hi) { return (bf16x8){lo[0], lo[1], lo[2], lo[3], hi[0], hi[1], hi[2], hi[3]}; }
__device__ __forceinline__ bf16x8 acc_frag(const f32x16& x, int s) {
    u32x4 w; w.x = cvt_pk_bf16(x[8 * s + 0], x[8 * s + 1]); w.y = cvt_pk_bf16(x[8 * s + 2], x[8 * s + 3]); w.z = cvt_pk_bf16(x[8 * s + 4], x[8 * s + 5]); w.w = cvt_pk_bf16(x[8 * s + 6], x[8 * s + 7]);
    return __builtin_bit_cast(bf16x8, w);
}
__device__ __forceinline__ int crow(int r, int h) { return (r & 3) + 8 * (r >> 2) + 4 * h; }

constexpr int ATT_KS = 144, ATT_VS = 192, ATT_VOFF = 256 * ATT_KS;
__device__ __forceinline__ void attn_unit(Frame& F, int unit) {
    const int n = unit & 15, kvh = (unit >> 4) & 1, b = unit >> 5;
    const int lane = F.lane, c = lane & 31, h = lane >> 5, hq = kvh * 8 + F.wave;
    bf16_t* QA = WSP(bf16_t, WS_QA); const bf16_t* KA = WSP(bf16_t, WS_KA); const bf16_t* VA = WSP(bf16_t, WS_VA);
    LAS unsigned char* Ks = F.lds; LAS unsigned char* Vs = F.lds + ATT_VOFF;
    const long tok0 = (long)b * SEQ + (long)(n - 1) * 128;
#pragma unroll
    for (int i = 0; i < 4; ++i) { const int piece = F.tid + 512 * i, key = piece >> 3, ch = piece & 7;
        u32x4 kv = (u32x4){0u, 0u, 0u, 0u}, vv = (u32x4){0u, 0u, 0u, 0u};
        if (n > 0 || key >= 128) { const size_t go = (size_t)(tok0 + key) * KVW + kvh * 64 + ch * 8; kv = *(const u32x4*)(KA + go); vv = *(const u32x4*)(VA + go); }
        *(LAS u32x4*)(Ks + key * ATT_KS + ch * 16) = kv; *(LAS u32x4*)(Vs + key * ATT_VS + ch * 16) = vv; }
    __syncthreads();
    const float sink2 = F.sinks[hq] * LOG2E;
    const int g2 = (lane >> 4) & 1, q4 = (lane & 15) >> 2, p4 = lane & 3;
    for (int j = 0; j < 4; ++j) {
        bf16_t* qp = QA + (size_t)(b * SEQ + n * 128 + 32 * j + c) * AW + hq * 64;
        bf16x8 qf[4];
#pragma unroll
        for (int s = 0; s < 4; ++s) qf[s] = *(const bf16x8*)(qp + 16 * s + 8 * h);
        f32x16 S[5];
#pragma unroll
        for (int t = 0; t < 5; ++t) { const int kt = j + t;
#pragma unroll
            for (int r = 0; r < 16; ++r) S[t][r] = 0.f;
#pragma unroll
            for (int s = 0; s < 4; ++s) { const bf16x8 a = *(const LAS bf16x8*)(Ks + (32 * kt + c) * ATT_KS + (16 * s + 8 * h) * 2); S[t] = mfma32(a, qf[s], S[t]); } }
        float mx = sink2;
#pragma unroll
        for (int t = 0; t < 5; ++t) { const bool tile_ok = (n > 0) || (j + t >= 4);
#pragma unroll
            for (int r = 0; r < 16; ++r) { const int row = crow(r, h); const bool ok = tile_ok && (t == 0 ? (row > c) : (t == 4 ? (row <= c) : true));
                S[t][r] = ok ? S[t][r] : -INFINITY; mx = fmaxf(mx, S[t][r]); } }
        mx = fmaxf(mx, __shfl_xor(mx, 32));
        float sum = 0.f;
#pragma unroll
        for (int t = 0; t < 5; ++t)
#pragma unroll
            for (int r = 0; r < 16; ++r) { const float p = __builtin_amdgcn_exp2f(S[t][r] - mx); S[t][r] = p; sum += p; }
        sum += __shfl_xor(sum, 32); sum += __builtin_amdgcn_exp2f(sink2 - mx);
        f32x16 O[2];
#pragma unroll
        for (int r = 0; r < 16; ++r) { O[0][r] = 0.f; O[1][r] = 0.f; }
#pragma unroll
        for (int t = 0; t < 5; ++t) { const int kt = j + t;
#pragma unroll
            for (int s = 0; s < 2; ++s) { const bf16x8 pb = acc_frag(S[t], s);
#pragma unroll
                for (int dt = 0; dt < 2; ++dt) { LAS unsigned char* vp = Vs + (32 * kt + 16 * s + 4 * h + q4) * ATT_VS + (32 * dt + 16 * g2 + 4 * p4) * 2;
                    const v4i16_t lo = tr_read(vp), hi = tr_read(vp + 8 * ATT_VS);
                    O[dt] = mfma32(cat44(lo, hi), pb, O[dt]); } } }
        const float inv = 1.0f / sum;
#pragma unroll
        for (int dt = 0; dt < 2; ++dt)
#pragma unroll
            for (int g = 0; g < 4; ++g) { u32x2 w; w.x = cvt_pk_bf16(O[dt][4 * g] * inv, O[dt][4 * g + 1] * inv); w.y = cvt_pk_bf16(O[dt][4 * g + 2] * inv, O[dt][4 * g + 3] * inv);
                *(u32x2*)(qp + 32 * dt + 8 * g + 4 * h) = w; }
    }
    __syncthreads();
}

constexpr int HG_KUT_S = 144, HG_VS_S = 320, HG_ROW_S = 272;
constexpr int HG_TOT = 0, HG_SSQ = 2048, HG_VS = 4096, HG_KUT = HG_VS + 64 * HG_VS_S, HG_QI = HG_VS + 64 * HG_VS_S, HG_QS = HG_QI + 64 * HG_ROW_S, HG_KSC = HG_QS + 64 * HG_ROW_S;
__device__ __forceinline__ void hg_cumsum(Frame& F, const bf16_t* LF, size_t base, float (&bc)[16], float& bmid, float& bL) {
    const int k = F.tid & 127, seg = F.tid >> 7;
    LAS float* tot = (LAS float*)(F.lds + HG_TOT);
    float run = 0.f;
#pragma unroll
    for (int i = 0; i < 16; ++i) { run += bf2f(LF[base + (size_t)(16 * seg + i) * HGW + k]); bc[i] = run; }
    tot[seg * 128 + k] = run;
    __syncthreads();
    const float t0 = tot[k], t1 = tot[128 + k], t2 = tot[256 + k], t3 = tot[384 + k];
    const float off = (seg > 0 ? t0 : 0.f) + (seg > 1 ? t1 : 0.f) + (seg > 2 ? t2 : 0.f);
#pragma unroll
    for (int i = 0; i < 16; ++i) bc[i] += off;
    bmid = t0 + t1; bL = (t0 + t1) + (t2 + t3);
}
__device__ __forceinline__ void hg_load_v(Frame& F, const bf16_t* IH, size_t base) {
#pragma unroll
    for (int i = 0; i < 2; ++i) { const int piece = F.tid + 512 * i, s = piece >> 4, ch = piece & 15;
        *(LAS u32x4*)(F.lds + HG_VS + s * HG_VS_S + ch * 16) = *(const u32x4*)(IH + base + (size_t)s * HGW + ch * 8); }
}
__device__ __forceinline__ void hgrn_passA_unit(Frame& F, int unit) {
    const int ch = unit & 31, bh = unit >> 5, h = bh & 7, b = bh >> 3;
    const size_t base = (size_t)(b * SEQ + 64 * ch) * HGW + h * 128;
    const int k = F.tid & 127, seg = F.tid >> 7;
    float bc[16], bmid, bL;
    hg_cumsum(F, WSP(bf16_t, WS_LF), base, bc, bmid, bL);
    const bf16_t* KH = WSP(bf16_t, WS_KH);
    float ku[16];
#pragma unroll
    for (int i = 0; i < 16; ++i) ku[i] = bf2f(KH[base + (size_t)(16 * seg + i) * HGW + k]) * __expf(bL - bc[i]);
    u32x4 w0, w1;
    w0.x = cvt_pk_bf16(ku[0], ku[1]); w0.y = cvt_pk_bf16(ku[2], ku[3]); w0.z = cvt_pk_bf16(ku[4], ku[5]); w0.w = cvt_pk_bf16(ku[6], ku[7]);
    w1.x = cvt_pk_bf16(ku[8], ku[9]); w1.y = cvt_pk_bf16(ku[10], ku[11]); w1.z = cvt_pk_bf16(ku[12], ku[13]); w1.w = cvt_pk_bf16(ku[14], ku[15]);
    *(LAS u32x4*)(F.lds + HG_KUT + k * HG_KUT_S + seg * 32) = w0; *(LAS u32x4*)(F.lds + HG_KUT + k * HG_KUT_S + seg * 32 + 16) = w1;
    if (seg == 0) WSP(float, WS_DEC)[(size_t)unit * 128 + k] = __expf(bL);
    hg_load_v(F, WSP(bf16_t, WS_IH), base);
    __syncthreads();
    const int lane = F.lane, c = lane & 31, hh = lane >> 5, g2 = (lane >> 4) & 1, q4 = (lane & 15) >> 2, p4 = lane & 3;
    const int kt = F.wave >> 1;
    f32x16 acc[2];
#pragma unroll
    for (int r = 0; r < 16; ++r) { acc[0][r] = 0.f; acc[1][r] = 0.f; }
#pragma unroll
    for (int ks = 0; ks < 4; ++ks) { const bf16x8 a = *(const LAS bf16x8*)(F.lds + HG_KUT + (32 * kt + c) * HG_KUT_S + (16 * ks + 8 * hh) * 2);
#pragma unroll
        for (int e = 0; e < 2; ++e) { const int vt = 2 * (F.wave & 1) + e; LAS unsigned char* vp = F.lds + HG_VS + (16 * ks + 8 * hh + q4) * HG_VS_S + (32 * vt + 16 * g2 + 4 * p4) * 2;
            const v4i16_t lo = tr_read(vp), hi = tr_read(vp + 4 * HG_VS_S);
            acc[e] = mfma32(a, cat44(lo, hi), acc[e]); } }
    bf16_t* US = (bf16_t*)((unsigned char*)F.out + OUT_US) + (size_t)unit * 16384;
#pragma unroll
    for (int e = 0; e < 2; ++e) { const int v = 32 * (2 * (F.wave & 1) + e) + c;
#pragma unroll
        for (int g = 0; g < 4; ++g) { u32x2 w; w.x = cvt_pk_bf16(acc[e][4 * g], acc[e][4 * g + 1]); w.y = cvt_pk_bf16(acc[e][4 * g + 2], acc[e][4 * g + 3]);
            *(u32x2*)(US + v * 128 + 32 * kt + 8 * g + 4 * hh) = w; } }
    __syncthreads();
}
__device__ __forceinline__ void hgrn_passB(Frame& F) {
    const bf16_t* __restrict__ US = (const bf16_t*)((unsigned char*)F.out + OUT_US); bf16_t* __restrict__ SS = (bf16_t*)((unsigned char*)F.out + OUT_SS);
    const float* __restrict__ DEC = WSP(float, WS_DEC);
    for (int idx = blockIdx.x * 512 + F.tid; idx < 64 * 2048; idx += F.G * 512) {
        const int bh = idx >> 11, e8 = idx & 2047, k8 = (e8 & 15) * 8;
        f32x4 s0 = (f32x4){0.f, 0.f, 0.f, 0.f}, s1 = s0;
        for (int c0 = 0; c0 < 32; c0 += 8) {
            u32x4 u[8]; f32x4 d0[8], d1[8];
#pragma unroll
            for (int i = 0; i < 8; ++i) { const size_t unit = (size_t)bh * 32 + c0 + i; u[i] = *(const u32x4*)(US + unit * 16384 + e8 * 8); d0[i] = *(const f32x4*)(DEC + unit * 128 + k8); d1[i] = *(const f32x4*)(DEC + unit * 128 + k8 + 4); }
#pragma unroll
            for (int i = 0; i < 8; ++i) { const size_t unit = (size_t)bh * 32 + c0 + i; *(u32x4*)(SS + unit * 16384 + e8 * 8) = pack8(s0, s1);
                f32x4 a, bb; unpack8(u[i], a, bb); s0 = d0[i] * s0 + a; s1 = d1[i] * s1 + bb; }
        }
    }
}
__device__ __forceinline__ void hgrn_passC_unit(Frame& F, int unit) {
    const int ch = unit & 31, bh = unit >> 5, h = bh & 7, b = bh >> 3;
    const int m0 = b * SEQ + 64 * ch;
    const size_t base = (size_t)m0 * HGW + h * 128;
    const int k = F.tid & 127, seg = F.tid >> 7;
    float bc[16], bmid, bL;
    hg_cumsum(F, WSP(bf16_t, WS_LF), base, bc, bmid, bL);
    { const bf16_t* QH = WSP(bf16_t, WS_QH); const bf16_t* KH = WSP(bf16_t, WS_KH);
#pragma unroll
      for (int i = 0; i < 16; ++i) { const int s = 16 * seg + i; const size_t go = base + (size_t)s * HGW + k;
          const float q = bf2f(QH[go]), kk = bf2f(KH[go]);
          const float eI = __expf(bc[i]), eS = __expf(bc[i] - bmid), eK = __expf(bmid - bc[i]);
          *(LAS bf16_t*)(F.lds + HG_QI + s * HG_ROW_S + k * 2) = (bf16_t)(cvt_pk_bf16(q * eI, 0.f) & 0xffffu);
          *(LAS bf16_t*)(F.lds + HG_QS + s * HG_ROW_S + k * 2) = (bf16_t)(cvt_pk_bf16(q * eS, 0.f) & 0xffffu);
          *(LAS bf16_t*)(F.lds + HG_KSC + s * HG_ROW_S + k * 2) = (bf16_t)(cvt_pk_bf16(kk * eK, 0.f) & 0xffffu); } }
    hg_load_v(F, WSP(bf16_t, WS_IH), base);
    __syncthreads();
    const int lane = F.lane, c = lane & 31, hh = lane >> 5, g2 = (lane >> 4) & 1, q4 = (lane & 15) >> 2, p4 = lane & 3;
    const int vt = F.wave & 3, tt = F.wave >> 2;
    f32x16 X[2];
#pragma unroll
    for (int st = 0; st < 2; ++st) {
#pragma unroll
        for (int r = 0; r < 16; ++r) X[st][r] = 0.f;
        if (st <= tt) {
#pragma unroll
            for (int ks = 0; ks < 8; ++ks) { const bf16x8 a = *(const LAS bf16x8*)(F.lds + HG_KSC + (32 * st + c) * HG_ROW_S + (16 * ks + 8 * hh) * 2);
                const bf16x8 bq = *(const LAS bf16x8*)(F.lds + HG_QS + (32 * tt + c) * HG_ROW_S + (16 * ks + 8 * hh) * 2); X[st] = mfma32(a, bq, X[st]); }
            if (st == tt) {
#pragma unroll
                for (int r = 0; r < 16; ++r) X[st][r] = (crow(r, hh) <= c) ? X[st][r] : 0.f; }
        }
    }
    f32x16 O;
#pragma unroll
    for (int r = 0; r < 16; ++r) O[r] = 0.f;
    const bf16_t* SS = (const bf16_t*)((unsigned char*)F.out + OUT_SS) + (size_t)unit * 16384;
#pragma unroll
    for (int ks = 0; ks < 8; ++ks) { const bf16x8 a = *(const bf16x8*)(SS + (32 * vt + c) * 128 + 16 * ks + 8 * hh);
        const bf16x8 bq = *(const LAS bf16x8*)(F.lds + HG_QI + (32 * tt + c) * HG_ROW_S + (16 * ks + 8 * hh) * 2); O = mfma32(a, bq, O); }
#pragma unroll
    for (int st = 0; st < 2; ++st) if (st <= tt) {
#pragma unroll
        for (int s2 = 0; s2 < 2; ++s2) { const bf16x8 pb = acc_frag(X[st], s2);
            LAS unsigned char* vp = F.lds + HG_VS + (32 * st + 16 * s2 + 4 * hh + q4) * HG_VS_S + (32 * vt + 16 * g2 + 4 * p4) * 2;
            const v4i16_t lo = tr_read(vp), hi = tr_read(vp + 8 * HG_VS_S);
            O = mfma32(cat44(lo, hi), pb, O); } }
    float ss = 0.f;
#pragma unroll
    for (int r = 0; r < 16; ++r) ss += O[r] * O[r];
    ss += __shfl_xor(ss, 32);
    LAS float* ssq = (LAS float*)(F.lds + HG_SSQ);
    if (hh == 0) ssq[(tt * 4 + vt) * 32 + c] = ss;
    __syncthreads();
    const float tot = (ssq[(tt * 4 + 0) * 32 + c] + ssq[(tt * 4 + 1) * 32 + c]) + (ssq[(tt * 4 + 2) * 32 + c] + ssq[(tt * 4 + 3) * 32 + c]);
    const float rstd = rsqrtf(tot * (1.0f / 128.0f) + EPS);
    bf16_t* HO = WSP(bf16_t, WS_QH); const bf16_t* GH = WSP(bf16_t, WS_GH);
    const size_t orow = (size_t)(m0 + 32 * tt + c) * HGW + h * 128;
#pragma unroll
    for (int g = 0; g < 4; ++g) { const int v0 = 32 * vt + 8 * g + 4 * hh;
        const u32x2 gw = *(const u32x2*)(GH + orow + v0); const f32x4 hn = *(const f32x4*)(F.hg_norm + v0);
        u32x2 w; w.x = cvt_pk_bf16(O[4 * g] * rstd * hn[0] * bflo(gw.x), O[4 * g + 1] * rstd * hn[1] * bfhi(gw.x));
        w.y = cvt_pk_bf16(O[4 * g + 2] * rstd * hn[2] * bflo(gw.y), O[4 * g + 3] * rstd * hn[3] * bfhi(gw.y));
        *(u32x2*)(HO + orow + v0) = w; }
    __syncthreads();
}

__device__ __forceinline__ void rows2(Frame& F) {
    const int gw = blockIdx.x * NWAVES + F.wave, NGW = F.G * NWAVES;
    const bf16_t* Y = WSP(bf16_t, WS_Y); bf16_t* H2 = WSP(bf16_t, WS_H2);
    for (int r0 = gw * 8; r0 < MTOK; r0 += NGW * 8) {
        const int b = r0 / SEQ;
        const float* mod = WSP(float, WS_MOD) + (size_t)b * NMODC;
        f32x4 g1[8], ga[8], sh[8];
#pragma unroll
        for (int j = 0; j < 8; ++j) { const int col = 4 * F.lane + 256 * j;
            g1[j] = *(const f32x4*)(mod + 2 * DM + col) * *(const f32x4*)(F.g_post_mix + col);
            ga[j] = *(const f32x4*)(F.g_pre_ffn + col) * (1.0f + *(const f32x4*)(mod + 4 * DM + col)); sh[j] = *(const f32x4*)(mod + 3 * DM + col); }
        for (int r = r0; r < r0 + 8; ++r) {
            const float* xr = F.x + (size_t)r * DM; const bf16_t* yr = Y + (size_t)r * DM;
            f32x4 v[8], y[8]; float ss = 0.f;
#pragma unroll
            for (int j = 0; j < 8; ++j) { v[j] = *(const f32x4*)(xr + 4 * F.lane + 256 * j); const u32x2 w = *(const u32x2*)(yr + 4 * F.lane + 256 * j);
                y[j] = (f32x4){bflo(w.x), bfhi(w.x), bflo(w.y), bfhi(w.y)}; ss += (y[j][0] * y[j][0] + y[j][1] * y[j][1]) + (y[j][2] * y[j][2] + y[j][3] * y[j][3]); }
            const float rstd = rsqrtf(wave_sum(ss) * (1.0f / DM) + EPS);
            float s2 = 0.f; float* orow = F.out + (size_t)r * DM;
#pragma unroll
            for (int j = 0; j < 8; ++j) { v[j] = v[j] + g1[j] * (y[j] * rstd); *(f32x4*)(orow + 4 * F.lane + 256 * j) = v[j];
                s2 += (v[j][0] * v[j][0] + v[j][1] * v[j][1]) + (v[j][2] * v[j][2] + v[j][3] * v[j][3]); }
            const float rstd2 = rsqrtf(wave_sum(s2) * (1.0f / DM) + EPS);
            bf16_t* hrow = H2 + (size_t)r * DM;
#pragma unroll
            for (int j = 0; j < 8; ++j) { const f32x4 h = v[j] * rstd2 * ga[j] + sh[j]; u32x2 w; w.x = cvt_pk_bf16(h[0], h[1]); w.y = cvt_pk_bf16(h[2], h[3]); *(u32x2*)(hrow + 4 * F.lane + 256 * j) = w; }
        }
    }
}
__device__ __forceinline__ void rows3(Frame& F) {
    const int gw = blockIdx.x * NWAVES + F.wave, NGW = F.G * NWAVES;
    const bf16_t* Y2 = WSP(bf16_t, WS_Y2);
    for (int r0 = gw * 8; r0 < MTOK; r0 += NGW * 8) {
        const int b = r0 / SEQ;
        const float* mod = WSP(float, WS_MOD) + (size_t)b * NMODC;
        f32x4 g2[8];
#pragma unroll
        for (int j = 0; j < 8; ++j) { const int col = 4 * F.lane + 256 * j; g2[j] = *(const f32x4*)(mod + 5 * DM + col) * *(const f32x4*)(F.g_post_ffn + col); }
        for (int r = r0; r < r0 + 8; ++r) {
            float* orow = F.out + (size_t)r * DM; const bf16_t* yr = Y2 + (size_t)r * DM;
            f32x4 v[8], y[8]; float ss = 0.f;
#pragma unroll
            for (int j = 0; j < 8; ++j) { v[j] = *(const f32x4*)(orow + 4 * F.lane + 256 * j); const u32x2 w = *(const u32x2*)(yr + 4 * F.lane + 256 * j);
                y[j] = (f32x4){bflo(w.x), bfhi(w.x), bflo(w.y), bfhi(w.y)}; ss += (y[j][0] * y[j][0] + y[j][1] * y[j][1]) + (y[j][2] * y[j][2] + y[j][3] * y[j][3]); }
            const float rstd = rsqrtf(wave_sum(ss) * (1.0f / DM) + EPS);
#pragma unroll
            for (int j = 0; j < 8; ++j) *(f32x4*)(orow + 4 * F.lane + 256 * j) = v[j] + g2[j] * (y[j] * rstd);
        }
    }
}

constexpr int NPH = 12;
struct Args { const void* in[18]; float* out; unsigned char* ws; int ph_lo, ph_hi; };
__global__ void __launch_bounds__(NWAVES * 64, 2) fwd_kernel(Args args) {
    extern __shared__ __attribute__((aligned(16))) unsigned char lds_raw[];
    Frame F;
    F.lds = (LAS unsigned char*)lds_raw;
    F.tid = threadIdx.x; F.lane = F.tid & 63; F.wave = __builtin_amdgcn_readfirstlane(F.tid >> 6);
    F.G = gridDim.x; { const int bx = blockIdx.x; F.vcu = (F.G % 8 == 0) ? (bx % 8) * (F.G / 8) + bx / 8 : bx; }
    F.x = (const float*)args.in[0]; F.c = (const float*)args.in[1]; F.positions = (const int*)args.in[2]; F.w_ada = (const float*)args.in[3]; F.b_ada = (const float*)args.in[4];
    F.g_pre_mix = (const float*)args.in[5]; F.g_post_mix = (const float*)args.in[6]; F.g_pre_ffn = (const float*)args.in[7]; F.g_post_ffn = (const float*)args.in[8];
    F.w_in = (const float*)args.in[9]; F.sinks = (const float*)args.in[10]; F.w_ap = (const float*)args.in[11]; F.hg_lb = (const float*)args.in[12]; F.hg_norm = (const float*)args.in[13];
    F.w_hp = (const float*)args.in[14]; F.w_out = (const float*)args.in[15]; F.w_fi = (const float*)args.in[16]; F.w_fo = (const float*)args.in[17];
    F.out = args.out; F.ws = args.ws;
    volatile LAS unsigned* MISC = (volatile LAS unsigned*)(F.lds + MISC_OFF);
    for (int u = F.tid; u < (LDS_BYTES - LDSCTL_OFF) / 4; u += NWAVES * 64) ((LAS unsigned*)(F.lds + LDSCTL_OFF))[u] = 0u;
    __syncthreads();
    const int lo = args.ph_lo, hi = args.ph_hi;
    XcdBarrier bar; bar.bar = WSP(unsigned, WS_CTL) + CW_BAR; bar.x = 0; bar.st = nullptr;
    if (hi - lo > 1) bar = xcd_barrier_post(WSP(unsigned, WS_CTL) + CW_BAR, MISC + 8);
#define IN(k) (lo <= (k) && (k) < hi)
#define SEAM(k) do { if (IN(k) && IN((k) + 1)) xcd_barrier(bar); } while (0)

    if (IN(0)) { p0_prologue(F); SEAM(0); }
    if (IN(1)) { p1_rows(F); SEAM(1); }
    if (IN(2)) {
        pg8::SingleOrder S; S.so.init(MTOK, INC, F.G, (int)blockIdx.x); S.A = (const char*)F.out + OUT_XN; S.B = (const char*)(F.ws + WS_WIN); S.tstep = (size_t)256 * DM * 2;
        EpiG1 E{F.ws, WSP(float, WS_ROPE), WSP(float, WS_LB)};
        pg8::gemm_phase<EpiG1, pg8::SingleOrder, true, true>(F.lds, DM, S, E);
        SEAM(2);
    }
    if (IN(3)) {
#if NAIVE_HGRN
        hgrn_naive_scan(F);
#endif
#if NAIVE_ATTN
        attn_naive(F);
#else
        for (int u = blockIdx.x; u < NB * 2 * 16; u += F.G) attn_unit(F, u);
#endif
#if !NAIVE_HGRN
        for (int u = blockIdx.x; u < 2048; u += F.G) hgrn_passA_unit(F, u);
#endif
        SEAM(3);
    }
    if (IN(4)) {
#if NAIVE_HGRN
        hgrn_naive_finish(F);
#else
        hgrn_passB(F);
#endif
        SEAM(4);
    }
    if (IN(5)) {
#if !NAIVE_HGRN
        for (int u = blockIdx.x; u < 2048; u += F.G) hgrn_passC_unit(F, u);
#endif
        SEAM(5);
    }
    if (IN(6)) {
        pg8::DualOrder S; S.so.init(MTOK, DM, F.G, (int)blockIdx.x); S.A0 = (const char*)(F.ws + WS_QA); S.B0 = (const char*)(F.ws + WS_WAP); S.A1 = (const char*)(F.ws + WS_QH); S.B1 = (const char*)(F.ws + WS_WHP); S.tstep = (size_t)256 * AW * 2;
        EpiMerge E{WSP(bf16_t, WS_GA), WSP(bf16_t, WS_GHT), WSP(bf16_t, WS_MERGED)};
        pg8::gemm_phase<EpiMerge, pg8::DualOrder, true, true>(F.lds, AW, S, E);
        SEAM(6);
    }
    if (IN(7)) {
        pg8::SingleOrder S; S.so.init(MTOK, DM, F.G, (int)blockIdx.x); S.A = (const char*)(F.ws + WS_MERGED); S.B = (const char*)(F.ws + WS_WOUT); S.tstep = (size_t)256 * DM * 2;
        EpiPlain E{WSP(bf16_t, WS_Y), DM};
        pg8::gemm_phase<EpiPlain, pg8::SingleOrder, true, true>(F.lds, DM, S, E);
        SEAM(7);
    }
    if (IN(8)) { rows2(F); SEAM(8); }
    if (IN(9)) {
        pg8::SingleOrder S; S.so.init(MTOK, 2 * FFH, F.G, (int)blockIdx.x); S.A = (const char*)(F.ws + WS_H2); S.B = (const char*)(F.ws + WS_WFI); S.tstep = (size_t)256 * DM * 2;
        EpiSwiGLU E{WSP(bf16_t, WS_ACT)};
        pg8::gemm_phase<EpiSwiGLU, pg8::SingleOrder, true, true>(F.lds, DM, S, E);
        SEAM(9);
    }
    if (IN(10)) {
        pg8::SingleOrder S; S.so.init(MTOK, DM, F.G, (int)blockIdx.x); S.A = (const char*)(F.ws + WS_ACT); S.B = (const char*)(F.ws + WS_WFO); S.tstep = (size_t)256 * FFH * 2;
        EpiPlain E{WSP(bf16_t, WS_Y2), DM};
        pg8::gemm_phase<EpiPlain, pg8::SingleOrder, true, true>(F.lds, FFH, S, E);
        SEAM(10);
    }
    if (IN(11)) { rows3(F); }
#undef IN
#undef SEAM
}

extern "C" void kernel_launch(void* const* d_in, const int* in_sizes, int n_in, void* d_out, int out_size, void* d_ws, size_t ws_size, hipStream_t stream) {
    static int grid = 0;
    if (grid == 0) {
        if (n_in != 18 || in_sizes[0] != MTOK * DM || out_size != MTOK * DM || ws_size < WS_END) { fprintf(stderr, "kernel_launch: unexpected shapes (n_in %d, out %d, ws %zu); nothing launched\n", n_in, out_size, ws_size); grid = -1; return; }
        int dev = 0, cus = 0, per_cu = 0;
        if (hipGetDevice(&dev) != hipSuccess || hipDeviceGetAttribute(&cus, hipDeviceAttributeMultiprocessorCount, dev) != hipSuccess) { grid = -1; return; }
        if (hipFuncSetAttribute((const void*)fwd_kernel, hipFuncAttributeMaxDynamicSharedMemorySize, LDS_BYTES) != hipSuccess) { fprintf(stderr, "kernel_launch: hipFuncSetAttribute failed\n"); grid = -1; return; }
        if (hipOccupancyMaxActiveBlocksPerMultiprocessor(&per_cu, (const void*)fwd_kernel, NWAVES * 64, LDS_BYTES) != hipSuccess || per_cu < 1) { fprintf(stderr, "kernel_launch: occupancy query says %d blocks per CU\n", per_cu); (void)hipGetLastError(); grid = -1; return; }
        grid = cus;
    }
    if (grid < 0) return;
    (void)hipMemsetAsync((char*)d_ws + WS_CTL, 0, CTL_ZERO_BYTES, stream);
    Args a{};
    for (int i = 0; i < 18; ++i) a.in[i] = d_in[i];
    a.out = (float*)d_out; a.ws = (unsigned char*)d_ws;
    if (MK_N_LAUNCHES == 1) { a.ph_lo = 0; a.ph_hi = NPH; hipLaunchKernelGGL(fwd_kernel, dim3(grid), dim3(NWAVES * 64), LDS_BYTES, stream, a); }
    else for (int p = 0; p < NPH; ++p) { a.ph_lo = p; a.ph_hi = p + 1; hipLaunchKernelGGL(fwd_kernel, dim3(grid), dim3(NWAVES * 64), LDS_BYTES, stream, a); }
}
```

```cpp
#include <hip/hip_runtime.h>
#include <cstdio>
#include <cstdint>

#ifndef MK_N_LAUNCHES
#define MK_N_LAUNCHES 1
#endif

#ifndef PROBE_DOUBLE
#define PROBE_DOUBLE -1
#endif
#ifndef NAIVE_ATTN
#define NAIVE_ATTN 0
#endif
#ifndef NAIVE_HGRN
#define NAIVE_HGRN 0
#endif

#define LAS __attribute__((address_space(3)))
#define GAS __attribute__((address_space(1)))
typedef unsigned short bf16_t;
typedef short bf16x8 __attribute__((ext_vector_type(8)));
typedef float f32x4 __attribute__((ext_vector_type(4)));
typedef float f32x2 __attribute__((ext_vector_type(2)));
typedef unsigned u32x4 __attribute__((ext_vector_type(4)));
typedef unsigned u32x2 __attribute__((ext_vector_type(2)));
typedef float f32x16 __attribute__((ext_vector_type(16)));
typedef short v4i16_t __attribute__((ext_vector_type(4)));

constexpr int NWAVES = 8;
constexpr int NB = 8, SEQ = 2048, DM = 2048, MTOK = NB * SEQ;
constexpr int AW = 1024, KVW = 128, HGW = 1024, FFH = 5632, INC = 9472, NMODC = 6 * DM;
constexpr float EPS = 1e-6f;
constexpr float LOG2E = 1.4426950408889634f;
constexpr float QSCALE = 0.125f * 1.4426950408889634f;

typedef __bf16 bf16x2_t __attribute__((ext_vector_type(2)));
__device__ __forceinline__ unsigned cvt_pk_bf16(float lo, float hi) { const f32x2 v = {lo, hi}; const bf16x2_t b = __builtin_convertvector(v, bf16x2_t); return __builtin_bit_cast(unsigned, b); }
__device__ __forceinline__ float bflo(unsigned w) { return __uint_as_float(w << 16); }
__device__ __forceinline__ float bfhi(unsigned w) { return __uint_as_float(w & 0xffff0000u); }
__device__ __forceinline__ float bf2f(bf16_t h) { return __uint_as_float((unsigned)h << 16); }
__device__ __forceinline__ float frcp(float x) { return __builtin_amdgcn_rcpf(x); }
__device__ __forceinline__ float fsigmoid(float x) { return frcp(1.0f + __expf(-x)); }
__device__ __forceinline__ u32x4 pack8(f32x4 a, f32x4 b) { u32x4 w; w.x = cvt_pk_bf16(a[0], a[1]); w.y = cvt_pk_bf16(a[2], a[3]); w.z = cvt_pk_bf16(b[0], b[1]); w.w = cvt_pk_bf16(b[2], b[3]); return w; }
__device__ __forceinline__ void unpack8(u32x4 w, f32x4& a, f32x4& b) { a = (f32x4){bflo(w.x), bfhi(w.x), bflo(w.y), bfhi(w.y)}; b = (f32x4){bflo(w.z), bfhi(w.z), bflo(w.w), bfhi(w.w)}; }

namespace pg8 {
constexpr int BM = 256, BK = 64, HALF = 128, HTB = HALF * BK * 2  , STAGE_BYTES = 8 * HTB, NXCD = 8, WGM = 8;

__host__ __device__ __forceinline__ int lds_byte(int r, int c) { const int st = (r >> 4) * 2 + (c >> 5), rr = r & 15, cc = c & 31, ob = rr * 64 + cc * 2; return st * 1024 + (ob ^ (((ob >> 9) & 1) << 5)); }
__host__ __device__ __forceinline__ void stage_rc(int b, int& R, int& C) { const int st = b / 1024, sb = b % 1024, swz = sb ^ (((sb >> 9) & 1) << 5); R = (st >> 1) * 16 + swz / 64; C = (st & 1) * 32 + (swz % 64) / 2; }
__host__ __device__ __forceinline__ int perm32(int rho) { const int n = rho >> 4, i = rho & 15; return 8 * (i >> 2) + 4 * n + (i & 3); }

struct Unit { int pm, pn, sub; };

struct StaticOrder {
    int nM, nN, nwg, G, c;
    __host__ __device__ void init(int M, int N, int G_, int c_) { nM = M / BM; nN = N / BM; nwg = nM * nN; G = G_; c = c_; }
    __host__ __device__ bool next(int i, Unit& u) const {
        const long L = (long)i * G + c; if (L >= nwg) return false;
        int wgid = (int)L; { const int q = nwg / NXCD, r = nwg % NXCD, xcd = wgid % NXCD, off = wgid / NXCD; wgid = (xcd < r ? xcd * (q + 1) : r * (q + 1) + (xcd - r) * q) + off; }
        const int nig = WGM * nN, gid = wgid / nig, fm = gid * WGM, gsz = (nM - fm) < WGM ? (nM - fm) : WGM;
        u.pm = fm + ((wgid % nig) % gsz); u.pn = (wgid % nig) / gsz; u.sub = 0; return true;
    }
};
struct SingleOrder {
    StaticOrder so; const char* A; const char* B; size_t tstep;
    __device__ __forceinline__ bool next(int i, Unit& u) const { return so.next(i, u); }
    __device__ __forceinline__ const char* aptr(const Unit& u) const { return A + (size_t)u.pm * tstep; }
    __device__ __forceinline__ const char* bptr(const Unit& u) const { return B + (size_t)u.pn * tstep; }
};
struct DualOrder {
    StaticOrder so; const char *A0, *B0, *A1, *B1; size_t tstep;
    __device__ __forceinline__ bool next(int i, Unit& u) const { if (!so.next(i >> 1, u)) return false; u.sub = i & 1; return true; }
    __device__ __forceinline__ const char* aptr(const Unit& u) const { return (u.sub ? A1 : A0) + (size_t)u.pm * tstep; }
    __device__ __forceinline__ const char* bptr(const Unit& u) const { return (u.sub ? B1 : B0) + (size_t)u.pn * tstep; }
};

typedef f32x4 Acc[2][2][4][2];

template <class Epi, class Sched, bool ALIGN_EPI, bool SP2>
__device__ __forceinline__ void gemm_phase(LAS unsigned char* lds, const int K, const Sched& S, const Epi& E) {
    const int tid = threadIdx.x, wid = __builtin_amdgcn_readfirstlane(tid >> 6), lane = tid & 63, wr = wid >> 2, wc = wid & 3, fr = lane & 15, fq = lane >> 4;
    const int nt = K / BK;
    unsigned voffA[2], voffB[2];
#pragma unroll
    for (int i = 0; i < 2; ++i) { int R, C; stage_rc(tid * 16 + i * 8192, R, C); const int Rb = ((R & ~31) + perm32(R & 31));
        voffA[i] = (unsigned)(R * K + C) * 2u; voffB[i] = (unsigned)(Rb * K + C) * 2u; }
    const size_t kstep = (size_t)(BK * 2);
    const size_t hstep = (size_t)HALF * K * 2;
    const unsigned ldsw = (unsigned)wid * 1024u;
    const int aoff = lds_byte(wr * 64 + fr, fq * 8), boff = lds_byte(wc * 32 + fr, fq * 8);
#define PG8_SA(b, h) (((b) * 2 + (h)) * HTB)
#define PG8_SB(b, h) ((4 + (b) * 2 + (h)) * HTB)
#define PG8_STAGE(bufoff, gbase, voff) do { _Pragma("unroll") for (int _i = 0; _i < 2; ++_i) \
        __builtin_amdgcn_global_load_lds((const unsigned*)((const char*)(gbase) + (voff)[_i]), (LAS unsigned*)(lds + (bufoff) + ldsw + _i * 8192), 16, 0, 0); } while (0)
#define PG8_LDA(dst, b, h) do { _Pragma("unroll") for (int m = 0; m < 4; ++m) _Pragma("unroll") for (int k = 0; k < 2; ++k) dst[m][k] = *(const LAS bf16x8*)(lds + PG8_SA(b, h) + aoff + m * 2048 + k * 1024); } while (0)
#define PG8_LDB(dst, b, h) do { _Pragma("unroll") for (int n = 0; n < 2; ++n) _Pragma("unroll") for (int k = 0; k < 2; ++k) dst[n][k] = *(const LAS bf16x8*)(lds + PG8_SB(b, h) + boff + n * 2048 + k * 1024); } while (0)
#define PG8_MMA(ai, bj, At, Bt) do { __builtin_amdgcn_s_setprio(1); _Pragma("unroll") for (int m = 0; m < 4; ++m) _Pragma("unroll") for (int n = 0; n < 2; ++n) _Pragma("unroll") for (int k = 0; k < 2; ++k) \
        acc[ai][bj][m][n] = __builtin_amdgcn_mfma_f32_16x16x32_bf16(Bt[n][k], At[m][k], acc[ai][bj][m][n], 0, 0, 0); __builtin_amdgcn_s_setprio(0); } while (0)
#define PG8_WAIT_V(n) asm volatile("s_waitcnt vmcnt(" #n ")" ::: "memory")
#define PG8_WAIT_L(n) asm volatile("s_waitcnt lgkmcnt(" #n ")" ::: "memory")
#define PG8_BAR __builtin_amdgcn_s_barrier()
#define PG8_SCHED __builtin_amdgcn_sched_barrier(0)
    Unit cur, nxt; int ui = 0;
    if (!S.next(0, cur)) return;
    Acc acc;
#pragma unroll
    for (int a = 0; a < 2; ++a)
#pragma unroll
        for (int b = 0; b < 2; ++b)
#pragma unroll
            for (int m = 0; m < 4; ++m)
#pragma unroll
                for (int n = 0; n < 2; ++n) acc[a][b][m][n] = (f32x4){0.f, 0.f, 0.f, 0.f};
    bf16x8 At[4][2], B0[2][2], B1[2][2];
    const char* cA = S.aptr(cur); const char* cB = S.bptr(cur);
    if constexpr (SP2) {
        PG8_STAGE(PG8_SB(0, 0), cB, voffB); PG8_STAGE(PG8_SB(0, 1), cB + hstep, voffB); PG8_STAGE(PG8_SA(0, 0), cA, voffA); PG8_STAGE(PG8_SA(0, 1), cA + hstep, voffA);
        if (wr == 1) PG8_BAR;
        PG8_WAIT_V(2); PG8_BAR;
        PG8_STAGE(PG8_SB(1, 0), cB + kstep, voffB); PG8_STAGE(PG8_SA(1, 0), cA + kstep, voffA); PG8_STAGE(PG8_SB(1, 1), cB + hstep + kstep, voffB);
        PG8_WAIT_V(6); PG8_BAR;
    } else {
        PG8_STAGE(PG8_SB(0, 0), cB, voffB); PG8_STAGE(PG8_SA(0, 0), cA, voffA); PG8_STAGE(PG8_SB(0, 1), cB + hstep, voffB); PG8_STAGE(PG8_SA(0, 1), cA + hstep, voffA);
        if (wr == 1) PG8_BAR;
        PG8_WAIT_V(4); PG8_BAR;
        PG8_STAGE(PG8_SB(1, 0), cB + kstep, voffB); PG8_STAGE(PG8_SA(1, 0), cA + kstep, voffA); PG8_STAGE(PG8_SB(1, 1), cB + hstep + kstep, voffB);
        PG8_WAIT_V(6); PG8_BAR;
    }
    for (;;) {
        const bool has_next = S.next(ui + 1, nxt);
        const char* nA = has_next ? S.aptr(nxt) : cA; const char* nB = has_next ? S.bptr(nxt) : cB;
        for (int t = 0; t < nt; t += 2) {
            const bool last = (t == nt - 2);
            const char* a1 = cA + (size_t)(t + 1) * kstep;
            const char* a2 = last ? nA : cA + (size_t)(t + 2) * kstep; const char* b2 = last ? nB : cB + (size_t)(t + 2) * kstep;
            const char* a3 = a2 + kstep; const char* b3 = b2 + kstep;
            if constexpr (SP2) {
            PG8_LDB(B0, 0, 0); PG8_LDB(B1, 0, 1); PG8_SCHED; PG8_LDA(At, 0, 0); PG8_STAGE(PG8_SA(1, 1), a1 + hstep, voffA);
            PG8_WAIT_V(8); PG8_WAIT_L(0); PG8_BAR; PG8_MMA(0, 0, At, B0); PG8_MMA(0, 1, At, B1); PG8_BAR; PG8_SCHED;
            PG8_LDA(At, 0, 1); PG8_STAGE(PG8_SB(0, 0), b2, voffB); PG8_STAGE(PG8_SB(0, 1), b2 + hstep, voffB); PG8_STAGE(PG8_SA(0, 0), a2, voffA);
            PG8_WAIT_V(8); PG8_WAIT_L(0); PG8_BAR; PG8_MMA(1, 0, At, B0); PG8_MMA(1, 1, At, B1); PG8_BAR; PG8_SCHED;
            PG8_LDB(B0, 1, 0); PG8_LDB(B1, 1, 1); PG8_SCHED; PG8_LDA(At, 1, 0); PG8_STAGE(PG8_SA(0, 1), a2 + hstep, voffA);
            PG8_WAIT_V(8); PG8_WAIT_L(0); PG8_BAR; PG8_MMA(0, 0, At, B0); PG8_MMA(0, 1, At, B1); PG8_BAR; PG8_SCHED;
            PG8_LDA(At, 1, 1); PG8_STAGE(PG8_SB(1, 0), b3, voffB); PG8_STAGE(PG8_SB(1, 1), b3 + hstep, voffB); PG8_STAGE(PG8_SA(1, 0), a3, voffA);
            PG8_WAIT_V(8); PG8_WAIT_L(0); PG8_BAR; PG8_MMA(1, 0, At, B0); PG8_MMA(1, 1, At, B1); PG8_BAR; PG8_SCHED;
            } else {
            PG8_LDB(B0, 0, 0); PG8_SCHED; PG8_LDA(At, 0, 0); PG8_STAGE(PG8_SA(1, 1), a1 + hstep, voffA);
            PG8_WAIT_L(8); PG8_BAR; PG8_WAIT_L(0); PG8_MMA(0, 0, At, B0); PG8_BAR; PG8_SCHED;
            PG8_LDB(B1, 0, 1); PG8_STAGE(PG8_SB(0, 0), b2, voffB);
            PG8_BAR; PG8_WAIT_L(0); PG8_MMA(0, 1, At, B1); PG8_BAR;
            PG8_LDA(At, 0, 1); PG8_STAGE(PG8_SA(0, 0), a2, voffA);
            PG8_BAR; PG8_WAIT_L(0); PG8_MMA(1, 0, At, B0); PG8_BAR; PG8_SCHED;
            PG8_STAGE(PG8_SB(0, 1), b2 + hstep, voffB);
            PG8_WAIT_V(6); PG8_BAR; PG8_MMA(1, 1, At, B1); PG8_BAR;
            PG8_LDB(B0, 1, 0); PG8_SCHED; PG8_LDA(At, 1, 0); PG8_STAGE(PG8_SA(0, 1), a2 + hstep, voffA);
            PG8_WAIT_L(8); PG8_BAR; PG8_WAIT_L(0); PG8_MMA(0, 0, At, B0); PG8_BAR; PG8_SCHED;
            PG8_LDB(B1, 1, 1); PG8_STAGE(PG8_SB(1, 0), b3, voffB);
            PG8_BAR; PG8_WAIT_L(0); PG8_MMA(0, 1, At, B1); PG8_BAR;
            PG8_LDA(At, 1, 1); PG8_STAGE(PG8_SA(1, 0), a3, voffA);
            PG8_BAR; PG8_WAIT_L(0); PG8_MMA(1, 0, At, B0); PG8_BAR; PG8_SCHED;
            PG8_STAGE(PG8_SB(1, 1), b3 + hstep, voffB);
            PG8_WAIT_V(6); PG8_BAR; PG8_MMA(1, 1, At, B1); PG8_BAR;
            }
        }
        if constexpr (ALIGN_EPI) { if (wr == 0) PG8_BAR; }
        E(acc, cur, wr, wc, fr, fq);
        if (!has_next) break;
        if (!Epi::keep_acc(cur)) {
#pragma unroll
        for (int a = 0; a < 2; ++a)
#pragma unroll
            for (int b = 0; b < 2; ++b)
#pragma unroll
                for (int m = 0; m < 4; ++m)
#pragma unroll
                    for (int n = 0; n < 2; ++n) acc[a][b][m][n] = (f32x4){0.f, 0.f, 0.f, 0.f};
        }
        cur = nxt; cA = nA; cB = nB; ++ui;
        if constexpr (ALIGN_EPI) { if (wr == 1) PG8_BAR; }
    }
    PG8_WAIT_V(0);
    if constexpr (!ALIGN_EPI) { if (wr == 0) PG8_BAR; }
    PG8_BAR;
#undef PG8_SA
#undef PG8_SB
#undef PG8_STAGE
#undef PG8_LDA
#undef PG8_LDB
#undef PG8_MMA
#undef PG8_WAIT_V
#undef PG8_WAIT_L
#undef PG8_BAR
#undef PG8_SCHED
}
}

constexpr size_t MiB = 1u << 20;
constexpr size_t WS_CTL = 0, CTL_ZERO_BYTES = 64 * 1024;
constexpr size_t WS_MOD = 1 * MiB;
constexpr size_t WS_LB = 1 * MiB + 512 * 1024;
constexpr size_t WS_ROPE = 2 * MiB;
constexpr size_t WS_DEC = 3 * MiB;
constexpr size_t WS_WIN = 4 * MiB, WS_WAP = 41 * MiB, WS_WHP = 45 * MiB, WS_WOUT = 49 * MiB, WS_WFI = 57 * MiB, WS_WFO = 101 * MiB;
constexpr size_t WS_QA = 128 * MiB, WS_QH = 160 * MiB, WS_KH = 192 * MiB, WS_LF = 224 * MiB, WS_IH = 256 * MiB, WS_GH = 288 * MiB;
constexpr size_t WS_KA = 320 * MiB, WS_VA = 324 * MiB, WS_GA = 328 * MiB, WS_GHT = 392 * MiB;
constexpr size_t WS_MERGED = 192 * MiB;
constexpr size_t WS_Y = 128 * MiB;
constexpr size_t WS_H2 = 256 * MiB;
constexpr size_t WS_ACT = 328 * MiB;
constexpr size_t WS_Y2 = 128 * MiB;
constexpr size_t WS_END = 504 * MiB;
constexpr size_t OUT_XN = 0, OUT_ORAW = 0, OUT_US = 64 * MiB, OUT_SS = 0;

constexpr int CW_BAR = 4096;

constexpr int RING_BYTES = 131072;
constexpr int LDSCTL_OFF = RING_BYTES, MISC_OFF = LDSCTL_OFF + 320;
constexpr int LDS_BYTES = 147456;

#define RLX_AGENT __ATOMIC_RELAXED, __HIP_MEMORY_SCOPE_AGENT
#define LDS_WAIT() asm volatile("s_waitcnt lgkmcnt(0)" ::: "memory")

#define XB_TMO      128
#define XB_XCNT(j)  (256  + 64 * (j))
#define XB_XSUB(j)  (1280 + 64 * (j))
#define XB_XGEN(j)  (2304 + 64 * (j))
#define XB_TOP      3328
#define XB_TOPGEN   3392
#define XCD_BAR_WORDS 3456
#define XB_SPIN_CAP (1u << 22)

__device__ __forceinline__ unsigned xb_ld(unsigned* p)              { return __hip_atomic_load(p, __ATOMIC_RELAXED, __HIP_MEMORY_SCOPE_AGENT); }
__device__ __forceinline__ unsigned xb_add(unsigned* p, unsigned v) { return __hip_atomic_fetch_add(p, v, __ATOMIC_RELAXED, __HIP_MEMORY_SCOPE_AGENT); }
__device__ __forceinline__ unsigned xb_xcc_id() { return (unsigned)__builtin_amdgcn_s_getreg((3 << 11) | 20) & 0xFu; }
#define XB_SPIN(cond, bar) do { unsigned _sp = 0; while (cond) { __builtin_amdgcn_s_sleep(1); \
    if ((++_sp & 255u) == 0u) { if (xb_ld(&(bar)[XB_TMO])) break; if (_sp > XB_SPIN_CAP) { atomicAdd(&(bar)[XB_TMO], 1u); break; } } } } while (0)

struct XcdBarrier { unsigned* bar; unsigned x; volatile LAS unsigned* st; };

__device__ __forceinline__ XcdBarrier xcd_barrier_post(unsigned* bar, volatile LAS unsigned* st) {
    XcdBarrier b; b.bar = bar; b.x = xb_xcc_id(); b.st = st;
    if (threadIdx.x == 0) (void)xb_add(&bar[XB_XCNT(b.x)], 1u);
    return b;
}
__device__ __forceinline__ void xcd_barrier_complete(unsigned* bar, unsigned x, unsigned& nloc, unsigned& nx) {
    const unsigned G = gridDim.x * gridDim.y * gridDim.z;
    unsigned sum, cnt, mine, sp = 0u;
    for (;;) {
        sum = 0u; cnt = 0u; mine = 0u;
#pragma unroll
        for (unsigned j = 0; j < 16; ++j) { const unsigned c = xb_ld(&bar[XB_XCNT(j)]); sum += c; cnt += (c > 0u) ? 1u : 0u; mine = (j == x) ? c : mine; }
        if (sum == G) break;
        __builtin_amdgcn_s_sleep(1);
        if ((++sp & 255u) == 0u) { if (xb_ld(&bar[XB_TMO])) break; if (sp > XB_SPIN_CAP) { atomicAdd(&bar[XB_TMO], 1u); break; } }
    }
    nloc = mine > 0u ? mine : 1u; nx = cnt > 0u ? cnt : 1u;
}
__device__ __forceinline__ void xcd_barrier(const XcdBarrier& b) {
    asm volatile("s_waitcnt vmcnt(0)" ::: "memory");
    __syncthreads();
    if (threadIdx.x == 0) {
        unsigned* bar = b.bar;
        __builtin_amdgcn_s_waitcnt(0);
        unsigned nloc = b.st[0], nx = b.st[1];
        if (nloc == 0u) { xcd_barrier_complete(bar, b.x, nloc, nx); b.st[0] = nloc; b.st[1] = nx; }
        const unsigned old = xb_add(&bar[XB_XSUB(b.x)], 1u);
        const unsigned gen = old / nloc;
        if (old + 1u == (gen + 1u) * nloc) {
            __builtin_amdgcn_fence(__ATOMIC_RELEASE, "agent");
            asm volatile("s_waitcnt vmcnt(0)" ::: "memory");
            const unsigned og = xb_add(&bar[XB_TOP], 1u);
            const unsigned tg = og / nx;
            if (og + 1u == (tg + 1u) * nx) xb_add(&bar[XB_TOPGEN], 1u);
            else XB_SPIN(xb_ld(&bar[XB_TOPGEN]) == tg, bar);
            __builtin_amdgcn_fence(__ATOMIC_ACQUIRE, "agent");
            xb_add(&bar[XB_XGEN(b.x)], 1u);
            asm volatile("s_waitcnt vmcnt(0)" ::: "memory");
        } else {
            XB_SPIN(xb_ld(&bar[XB_XGEN(b.x)]) == gen, bar);
            __builtin_amdgcn_fence(__ATOMIC_ACQUIRE, "agent");
            asm volatile("s_waitcnt vmcnt(0)" ::: "memory");
        }
    }
    __syncthreads();
}

struct Frame {
    LAS unsigned char* lds;
    int tid, lane, wave, vcu, G;
    const float *x, *c, *w_ada, *b_ada, *g_pre_mix, *g_post_mix, *g_pre_ffn, *g_post_ffn, *w_in, *sinks, *w_ap, *hg_lb, *hg_norm, *w_hp, *w_out, *w_fi, *w_fo;
    const int* positions;
    float* out;
    unsigned char* ws;
};
#define WSP(T, off) ((T*)(F.ws + (off)))

__device__ __forceinline__ float wave_sum(float v) {
#pragma unroll
    for (int o = 1; o < 64; o <<= 1) v += __shfl_xor(v, o);
    return v;
}

__device__ __forceinline__ int win_dst(int n) {
    if (n < AW + KVW) { int p = n & 63; if (p >= 4 && p < 12) p = (p < 8) ? p + 4 : p - 4; return (n & ~63) + p; }
    return n;
}
__device__ __forceinline__ int wfi_dst(int n) {
    if (n < FFH) return 256 * (n >> 7) + (n & 127);
    n -= FFH; return 256 * (n >> 7) + 128 + (n & 127);
}
template <int MODE>
__device__ __forceinline__ void p0_conv_item(const float* __restrict__ W, int K, int N, bf16_t* __restrict__ WT, int item, int lane) {
    const int nblk = N >> 7, kb = item / nblk, nb = item - kb * nblk;
    const int k0 = 64 * kb + 32 * (lane >> 5), n = 128 * nb + 4 * (lane & 31);
    const float* src = W + (size_t)k0 * N + n;
    size_t rows[4];
#pragma unroll
    for (int e = 0; e < 4; ++e) { const int nn = n + e; rows[e] = (size_t)((MODE == 1) ? win_dst(nn) : (MODE == 2) ? wfi_dst(nn) : nn) * K + k0; }
#pragma unroll
    for (int half = 0; half < 2; ++half) {
        f32x4 v[16];
#pragma unroll
        for (int i = 0; i < 16; ++i) v[i] = __builtin_nontemporal_load((const f32x4*)(src + (size_t)(16 * half + i) * N));
#pragma unroll
        for (int e = 0; e < 4; ++e)
#pragma unroll
            for (int pc = 0; pc < 2; ++pc) { u32x4 o; o.x = cvt_pk_bf16(v[8 * pc + 0][e], v[8 * pc + 1][e]); o.y = cvt_pk_bf16(v[8 * pc + 2][e], v[8 * pc + 3][e]);
                o.z = cvt_pk_bf16(v[8 * pc + 4][e], v[8 * pc + 5][e]); o.w = cvt_pk_bf16(v[8 * pc + 6][e], v[8 * pc + 7][e]);
                *(u32x4*)(WT + rows[e] + 16 * half + 8 * pc) = o; }
    }
}
constexpr int CI_IN = (DM / 64) * (INC / 128), CI_AP = (AW / 64) * (DM / 128), CI_HP = (HGW / 64) * (DM / 128), CI_OUT = (DM / 64) * (DM / 128), CI_FI = (DM / 64) * (2 * FFH / 128), CI_FO = (FFH / 64) * (DM / 128);
constexpr int N_CONV_ITEMS = CI_IN + CI_AP + CI_HP + CI_OUT + CI_FI + CI_FO;
__device__ __forceinline__ void p0_convert_item(Frame& F, int it) {
    int r = it;
    if (r < CI_IN) { p0_conv_item<1>(F.w_in, DM, INC, WSP(bf16_t, WS_WIN), r, F.lane); return; } r -= CI_IN;
    if (r < CI_AP) { p0_conv_item<0>(F.w_ap, AW, DM, WSP(bf16_t, WS_WAP), r, F.lane); return; } r -= CI_AP;
    if (r < CI_HP) { p0_conv_item<0>(F.w_hp, HGW, DM, WSP(bf16_t, WS_WHP), r, F.lane); return; } r -= CI_HP;
    if (r < CI_OUT) { p0_conv_item<0>(F.w_out, DM, DM, WSP(bf16_t, WS_WOUT), r, F.lane); return; } r -= CI_OUT;
    if (r < CI_FI) { p0_conv_item<2>(F.w_fi, DM, 2 * FFH, WSP(bf16_t, WS_WFI), r, F.lane); return; } r -= CI_FI;
    p0_conv_item<0>(F.w_fo, FFH, DM, WSP(bf16_t, WS_WFO), r, F.lane);
}
constexpr int N_MOD_ITEMS = NMODC / 64;

__device__ __forceinline__ double rope_rev(int f) {
    switch (f) { case 0: return 0.15915494309189535; case 1: return 0.03086376340470123; case 2: return 0.005985185712713705; case 3: return 0.001160663641240061;
                 case 4: return 0.00022507907903927653; case 5: return 4.364795279280289e-05; case 6: return 8.464330808241401e-06; default: return 1.6414262627950345e-06; }
}

__device__ __forceinline__ void p0_prologue(Frame& F) {
    for (int idx = blockIdx.x * 512 + F.tid; idx < MTOK * 8; idx += F.G * 512) {
        const int m = idx >> 3, f = idx & 7;
        const double rev = (double)F.positions[m] * rope_rev(f);
        const float fr = (float)(rev - floor(rev));
        float* rp = WSP(float, WS_ROPE) + (size_t)m * 16;
        rp[f] = __builtin_amdgcn_cosf(fr); rp[8 + f] = __builtin_amdgcn_sinf(fr);
        if (idx < HGW) { const float a0 = F.hg_lb[idx], a1 = F.hg_lb[HGW + idx]; WSP(float, WS_LB)[idx] = 1.0f / (1.0f + __expf(a1 - a0)); }
    }
    if ((int)blockIdx.x < N_MOD_ITEMS) {
        const int item = blockIdx.x;
        LAS float* cT = (LAS float*)F.lds + F.wave * 2048;
        LAS float* red = (LAS float*)(F.lds + 65536);
        const int k0 = F.wave * 256;
#pragma unroll 4
        for (int i = 0; i < 32; ++i) { const int idx = i * 64 + F.lane; cT[idx] = F.c[(idx & 7) * DM + k0 + (idx >> 3)]; }
        LDS_WAIT(); asm volatile("" ::: "memory");
        float acc[8];
#pragma unroll
        for (int b = 0; b < 8; ++b) acc[b] = 0.f;
        const float* wp = F.w_ada + (size_t)k0 * NMODC + item * 64 + F.lane;
#pragma unroll 16
        for (int k = 0; k < 256; ++k) {
            const float w = wp[(size_t)k * NMODC];
            const f32x4 c0 = *(const LAS f32x4*)(cT + k * 8), c1 = *(const LAS f32x4*)(cT + k * 8 + 4);
            acc[0] += w * c0[0]; acc[1] += w * c0[1]; acc[2] += w * c0[2]; acc[3] += w * c0[3];
            acc[4] += w * c1[0]; acc[5] += w * c1[1]; acc[6] += w * c1[2]; acc[7] += w * c1[3];
        }
#pragma unroll
        for (int b = 0; b < 8; ++b) red[(F.wave * 8 + b) * 64 + F.lane] = acc[b];
        __syncthreads();
        float s = F.b_ada[item * 64 + F.lane];
#pragma unroll
        for (int w = 0; w < 8; ++w) s += red[(w * 8 + F.wave) * 64 + F.lane];
        WSP(float, WS_MOD)[F.wave * NMODC + item * 64 + F.lane] = s;
        __syncthreads();
    }
    constexpr int CONV_EXTRA = 11;
    int first = 0;
    if ((int)F.G > N_MOD_ITEMS) {
        first = ((int)F.G - N_MOD_ITEMS) * CONV_EXTRA;
        if ((int)blockIdx.x >= N_MOD_ITEMS) for (int j = F.wave; j < CONV_EXTRA; j += NWAVES) p0_convert_item(F, ((int)blockIdx.x - N_MOD_ITEMS) * CONV_EXTRA + j);
    }
    for (int it = first + blockIdx.x * NWAVES + F.wave; it < N_CONV_ITEMS; it += F.G * NWAVES) p0_convert_item(F, it);
}

__device__ __forceinline__ void p1_rows(Frame& F) {
    const int gw = blockIdx.x * NWAVES + F.wave, NGW = F.G * NWAVES;
    bf16_t* XN = (bf16_t*)((unsigned char*)F.out + OUT_XN);
    for (int r0 = gw * 8; r0 < MTOK; r0 += NGW * 8) {
        const int b = r0 / SEQ;
        const float* mod = WSP(float, WS_MOD) + (size_t)b * NMODC;
        f32x4 ga[8], sh[8];
#pragma unroll
        for (int j = 0; j < 8; ++j) { const int col = 4 * F.lane + 256 * j;
            const f32x4 g = *(const f32x4*)(F.g_pre_mix + col), sc = *(const f32x4*)(mod + DM + col); sh[j] = *(const f32x4*)(mod + col); ga[j] = g * (1.0f + sc); }
        for (int r = r0; r < r0 + 8; ++r) {
            const float* xr = F.x + (size_t)r * DM;
            f32x4 v[8]; float ss = 0.f;
#pragma unroll
            for (int j = 0; j < 8; ++j) { v[j] = *(const f32x4*)(xr + 4 * F.lane + 256 * j); ss += (v[j][0] * v[j][0] + v[j][1] * v[j][1]) + (v[j][2] * v[j][2] + v[j][3] * v[j][3]); }
            const float rstd = rsqrtf(wave_sum(ss) * (1.0f / DM) + EPS);
            bf16_t* orow = XN + (size_t)r * DM;
#pragma unroll
            for (int j = 0; j < 8; ++j) { const f32x4 h = v[j] * rstd * ga[j] + sh[j]; u32x2 w; w.x = cvt_pk_bf16(h[0], h[1]); w.y = cvt_pk_bf16(h[2], h[3]); *(u32x2*)(orow + 4 * F.lane + 256 * j) = w; }
        }
    }
}

struct EpiG1 {
    unsigned char* ws; const float* rope; const float* lbv;
    static __device__ __forceinline__ bool keep_acc(const pg8::Unit&) { return false; }
    __device__ __forceinline__ void operator()(pg8::Acc& acc, const pg8::Unit& u, int wr, int wc, int fr, int fq) const {
        const int pn = u.pn; const int row0 = u.pm * 256 + wr * 64 + fr; const int cl = wc * 32 + 8 * fq;
        if (pn <= 4) {
            const bool dorope = ((wc & 1) == 0) && (fq < 2);
#pragma unroll
            for (int ai = 0; ai < 2; ++ai)
#pragma unroll
                for (int m = 0; m < 4; ++m) { const int row = row0 + ai * 128 + m * 16;
                    f32x4 cs = (f32x4){1.f, 1.f, 1.f, 1.f}, sn = (f32x4){0.f, 0.f, 0.f, 0.f};
                    if (dorope) { const float* rp = rope + (size_t)row * 16 + 4 * fq; cs = *(const f32x4*)rp; sn = *(const f32x4*)(rp + 8); }
#pragma unroll
                    for (int bj = 0; bj < 2; ++bj) { f32x4 v0 = acc[ai][bj][m][0], v1 = acc[ai][bj][m][1];
                        const bool isv = (pn == 4 && bj == 1);
                        if (dorope && !isv) { const f32x4 n0 = v0 * cs - v1 * sn, n1 = v1 * cs + v0 * sn; v0 = n0; v1 = n1; }
                        bf16_t* dst;
                        if (pn < 4) { v0 = v0 * QSCALE; v1 = v1 * QSCALE; dst = (bf16_t*)(ws + WS_QA) + (size_t)row * AW + pn * 256 + bj * 128 + cl; }
                        else dst = (bf16_t*)(ws + (bj == 0 ? WS_KA : WS_VA)) + (size_t)row * KVW + cl;
                        *(u32x4*)dst = pack8(v0, v1); } }
        } else if (pn <= 8) {
#pragma unroll
            for (int ai = 0; ai < 2; ++ai)
#pragma unroll
                for (int m = 0; m < 4; ++m) { const int row = row0 + ai * 128 + m * 16;
#pragma unroll
                    for (int bj = 0; bj < 2; ++bj) { f32x4 v0 = acc[ai][bj][m][0], v1 = acc[ai][bj][m][1];
#pragma unroll
                        for (int e = 0; e < 4; ++e) { v0[e] = v0[e] * fsigmoid(v0[e]); v1[e] = v1[e] * fsigmoid(v1[e]); }
                        *(u32x4*)((bf16_t*)(ws + WS_QH) + (size_t)row * HGW + (pn - 5) * 256 + bj * 128 + cl) = pack8(v0, v1); } }
        } else if (pn <= 12) {
#pragma unroll
            for (int bj = 0; bj < 2; ++bj) { const int col = (pn - 9) * 256 + bj * 128 + cl;
                const f32x4 lb0 = *(const f32x4*)(lbv + col), lb1 = *(const f32x4*)(lbv + col + 4);
#pragma unroll
                for (int ai = 0; ai < 2; ++ai)
#pragma unroll
                    for (int m = 0; m < 4; ++m) { const int row = row0 + ai * 128 + m * 16;
                        const f32x4 x0 = acc[ai][bj][m][0], x1 = acc[ai][bj][m][1]; f32x4 k0, k1, l0, l1;
#pragma unroll
                        for (int e = 0; e < 4; ++e) {
                            { const float xx = fminf(fmaxf(x0[e], -30.f), 30.f), ex = __expf(-xx), sg = frcp(1.0f + ex), om = 1.0f - lb0[e]; k0[e] = om * (ex * sg); l0[e] = __logf(lb0[e] + om * sg); }
                            { const float xx = fminf(fmaxf(x1[e], -30.f), 30.f), ex = __expf(-xx), sg = frcp(1.0f + ex), om = 1.0f - lb1[e]; k1[e] = om * (ex * sg); l1[e] = __logf(lb1[e] + om * sg); } }
                        *(u32x4*)((bf16_t*)(ws + WS_KH) + (size_t)row * HGW + col) = pack8(k0, k1);
                        *(u32x4*)((bf16_t*)(ws + WS_LF) + (size_t)row * HGW + col) = pack8(l0, l1); } }
        } else {
            bf16_t* base; int ldc, colt;
            if (pn <= 16) { base = (bf16_t*)(ws + WS_IH); ldc = HGW; colt = (pn - 13) * 256; }
            else if (pn <= 20) { base = (bf16_t*)(ws + WS_GH); ldc = HGW; colt = (pn - 17) * 256; }
            else if (pn <= 28) { base = (bf16_t*)(ws + WS_GA); ldc = DM; colt = (pn - 21) * 256; }
            else { base = (bf16_t*)(ws + WS_GHT); ldc = DM; colt = (pn - 29) * 256; }
            const bool sig = pn > 16;
#pragma unroll
            for (int ai = 0; ai < 2; ++ai)
#pragma unroll
                for (int m = 0; m < 4; ++m) { const int row = row0 + ai * 128 + m * 16;
#pragma unroll
                    for (int bj = 0; bj < 2; ++bj) { f32x4 v0 = acc[ai][bj][m][0], v1 = acc[ai][bj][m][1];
                        if (sig) {
#pragma unroll
                            for (int e = 0; e < 4; ++e) { v0[e] = fsigmoid(v0[e]); v1[e] = fsigmoid(v1[e]); } }
                        *(u32x4*)(base + (size_t)row * ldc + colt + bj * 128 + cl) = pack8(v0, v1); } }
        }
    }
};
struct EpiMerge {
    const bf16_t* ga; const bf16_t* gh; bf16_t* out;
    static __device__ __forceinline__ bool keep_acc(const pg8::Unit& u) { return u.sub == 0; }
    __device__ __forceinline__ void operator()(pg8::Acc& acc, const pg8::Unit& u, int wr, int wc, int fr, int fq) const {
        const int row0 = u.pm * 256 + wr * 64 + fr; const int col0 = u.pn * 256 + wc * 32 + 8 * fq;
#pragma unroll
        for (int ai = 0; ai < 2; ++ai)
#pragma unroll
            for (int m = 0; m < 4; ++m) { const size_t ro = (size_t)(row0 + ai * 128 + m * 16) * DM + col0;
#pragma unroll
                for (int bj = 0; bj < 2; ++bj) { f32x4 h0, h1; unpack8(*(const u32x4*)(gh + ro + bj * 128), h0, h1);
                    if (u.sub == 0) { f32x4 a0, a1; unpack8(*(const u32x4*)(ga + ro + bj * 128), a0, a1);
#pragma unroll
                        for (int e = 0; e < 4; ++e) { acc[ai][bj][m][0][e] *= a0[e] * frcp(h0[e]); acc[ai][bj][m][1][e] *= a1[e] * frcp(h1[e]); }
                    } else *(u32x4*)(out + ro + bj * 128) = pack8(acc[ai][bj][m][0] * h0, acc[ai][bj][m][1] * h1); } }
    }
};
struct EpiPlain {
    bf16_t* out; int ldc;
    static __device__ __forceinline__ bool keep_acc(const pg8::Unit&) { return false; }
    __device__ __forceinline__ void operator()(pg8::Acc& acc, const pg8::Unit& u, int wr, int wc, int fr, int fq) const {
        const int row0 = u.pm * 256 + wr * 64 + fr; const int col0 = u.pn * 256 + wc * 32 + 8 * fq;
#pragma unroll
        for (int ai = 0; ai < 2; ++ai)
#pragma unroll
            for (int m = 0; m < 4; ++m) { bf16_t* rp = out + (size_t)(row0 + ai * 128 + m * 16) * ldc + col0;
#pragma unroll
                for (int bj = 0; bj < 2; ++bj) *(u32x4*)(rp + bj * 128) = pack8(acc[ai][bj][m][0], acc[ai][bj][m][1]); }
    }
};
struct EpiSwiGLU {
    bf16_t* out;
    static __device__ __forceinline__ bool keep_acc(const pg8::Unit&) { return false; }
    __device__ __forceinline__ void operator()(pg8::Acc& acc, const pg8::Unit& u, int wr, int wc, int fr, int fq) const {
        const int row0 = u.pm * 256 + wr * 64 + fr; const int col0 = u.pn * 128 + wc * 32 + 8 * fq;
#pragma unroll
        for (int ai = 0; ai < 2; ++ai)
#pragma unroll
            for (int m = 0; m < 4; ++m) { f32x4 v0, v1;
#pragma unroll
                for (int e = 0; e < 4; ++e) { const float g0 = acc[ai][0][m][0][e], g1 = acc[ai][0][m][1][e]; v0[e] = g0 * fsigmoid(g0) * acc[ai][1][m][0][e]; v1[e] = g1 * fsigmoid(g1) * acc[ai][1][m][1][e]; }
                *(u32x4*)(out + (size_t)(row0 + ai * 128 + m * 16) * FFH + col0) = pack8(v0, v1); }
    }
};

__device__ __forceinline__ void attn_naive(Frame& F) {
    bf16_t* QA = WSP(bf16_t, WS_QA); const bf16_t* KA = WSP(bf16_t, WS_KA); const bf16_t* VA = WSP(bf16_t, WS_VA);
    for (int it = blockIdx.x * 512 + F.tid; it < MTOK * 16; it += F.G * 512) {
        const int m = it >> 4, hq = it & 15, b = m >> 11, s = m & 2047, kvh = hq >> 3;
        float q[64], o[64];
        bf16_t* qp = QA + (size_t)m * AW + hq * 64;
#pragma unroll
        for (int c = 0; c < 8; ++c) { const u32x4 w = *(const u32x4*)(qp + 8 * c); f32x4 a, bb; unpack8(w, a, bb);
#pragma unroll
            for (int e = 0; e < 4; ++e) { q[8 * c + e] = a[e]; q[8 * c + 4 + e] = bb[e]; } }
#pragma unroll
        for (int d = 0; d < 64; ++d) o[d] = 0.f;
        float mrun = F.sinks[hq] * LOG2E, den = 1.f;
        const int j0 = s >= 127 ? s - 127 : 0;
        for (int j = j0; j <= s; ++j) {
            const bf16_t* kr = KA + (size_t)(b * SEQ + j) * KVW + kvh * 64; const bf16_t* vr = VA + (size_t)(b * SEQ + j) * KVW + kvh * 64;
            float l = 0.f;
#pragma unroll
            for (int c = 0; c < 8; ++c) { f32x4 a, bb; unpack8(*(const u32x4*)(kr + 8 * c), a, bb);
#pragma unroll
                for (int e = 0; e < 4; ++e) { l += q[8 * c + e] * a[e]; l += q[8 * c + 4 + e] * bb[e]; } }
            const float mn = fmaxf(mrun, l), sc = exp2f(mrun - mn), p = exp2f(l - mn);
            den = den * sc + p; mrun = mn;
#pragma unroll
            for (int c = 0; c < 8; ++c) { f32x4 a, bb; unpack8(*(const u32x4*)(vr + 8 * c), a, bb);
#pragma unroll
                for (int e = 0; e < 4; ++e) { o[8 * c + e] = o[8 * c + e] * sc + p * a[e]; o[8 * c + 4 + e] = o[8 * c + 4 + e] * sc + p * bb[e]; } }
        }
        const float inv = 1.0f / den;
#pragma unroll
        for (int c = 0; c < 8; ++c) { f32x4 a, bb;
#pragma unroll
            for (int e = 0; e < 4; ++e) { a[e] = o[8 * c + e] * inv; bb[e] = o[8 * c + 4 + e] * inv; }
            *(u32x4*)(qp + 8 * c) = pack8(a, bb); }
    }
}
__device__ __forceinline__ void hgrn_naive_scan(Frame& F) {
    if (F.wave != 0 || (int)blockIdx.x >= 128) return;
    const int item = blockIdx.x, bh = item >> 1, vh = item & 1, b = bh >> 3, h = bh & 7;
    const bf16_t* QH = WSP(bf16_t, WS_QH); const bf16_t* KH = WSP(bf16_t, WS_KH); const bf16_t* LF = WSP(bf16_t, WS_LF); const bf16_t* IH = WSP(bf16_t, WS_IH);
    float* ORAW = (float*)((unsigned char*)F.out + OUT_ORAW);
    float st[128];
#pragma unroll
    for (int k = 0; k < 128; ++k) st[k] = 0.f;
    for (int t = 0; t < SEQ; ++t) {
        const size_t ro = (size_t)(b * SEQ + t) * HGW + h * 128;
        const float v = bf2f(IH[ro + vh * 64 + F.lane]);
        float o = 0.f;
#pragma unroll
        for (int c = 0; c < 16; ++c) { f32x4 q0, q1, k0, k1, l0, l1;
            unpack8(*(const u32x4*)(QH + ro + 8 * c), q0, q1); unpack8(*(const u32x4*)(KH + ro + 8 * c), k0, k1); unpack8(*(const u32x4*)(LF + ro + 8 * c), l0, l1);
#pragma unroll
            for (int e = 0; e < 4; ++e) {
                { const float f = exp2f(l0[e] * LOG2E); st[8 * c + e] = f * st[8 * c + e] + k0[e] * v; o += st[8 * c + e] * q0[e]; }
                { const float f = exp2f(l1[e] * LOG2E); st[8 * c + 4 + e] = f * st[8 * c + 4 + e] + k1[e] * v; o += st[8 * c + 4 + e] * q1[e]; } } }
        ORAW[ro + vh * 64 + F.lane] = o;
    }
}
__device__ __forceinline__ void hgrn_naive_finish(Frame& F) {
    const float* ORAW = (const float*)((unsigned char*)F.out + OUT_ORAW);
    bf16_t* HO = WSP(bf16_t, WS_QH); const bf16_t* GH = WSP(bf16_t, WS_GH);
    const int gw = blockIdx.x * NWAVES + F.wave, NGW = F.G * NWAVES;
    for (int it = gw; it < MTOK * 8; it += NGW) {
        const size_t ro = (size_t)(it >> 3) * HGW + (it & 7) * 128 + 2 * F.lane;
        const f32x2 o = *(const f32x2*)(ORAW + ro);
        const float rstd = rsqrtf(wave_sum(o[0] * o[0] + o[1] * o[1]) * (1.0f / 128.0f) + EPS);
        const f32x2 g = *(const f32x2*)(F.hg_norm + 2 * F.lane);
        const unsigned gw2 = *(const unsigned*)(GH + ro);
        *(unsigned*)(HO + ro) = cvt_pk_bf16(o[0] * rstd * g[0] * bflo(gw2), o[1] * rstd * g[1] * bfhi(gw2));
    }
}

__device__ __forceinline__ f32x16 mfma32(bf16x8 a, bf16x8 b, f32x16 c) { return __builtin_amdgcn_mfma_f32_32x32x16_bf16(a, b, c, 0, 0, 0); }
__device__ __forceinline__ v4i16_t tr_read(LAS unsigned char* p) { return __builtin_amdgcn_ds_read_tr16_b64_v4i16((LAS v4i16_t*)p); }
__device__ __forceinline__ bf16x8 cat44(v4i16_t lo, v4i16_t hi) { return (bf16x8){lo[0], lo[1], lo[2], lo[3], hi[0], hi[1], hi[2], hi[3]}; }
__device__ __forceinline__ bf16x8 acc_frag(const f32x16& x, int s) {
    u32x4 w; w.x = cvt_pk_bf16(x[8 * s + 0], x[8 * s + 1]); w.y = cvt_pk_bf16(x[8 * s + 2], x[8 * s + 3]); w.z = cvt_pk_bf16(x[8 * s + 4], x[8 * s + 5]); w.w = cvt_pk_bf16(x[8 * s + 6], x[8 * s + 7]);
    return __builtin_bit_cast(bf16x8, w);
}
__device__ __forceinline__ int crow(int r, int h) { return (r & 3) + 8 * (r >> 2) + 4 * h; }

constexpr int ATT_KS = 144, ATT_VS = 192, ATT_VOFF = 256 * ATT_KS;
__device__ __forceinline__ void attn_unit(Frame& F, int unit) {
    const int n = unit & 15, kvh = (unit >> 4) & 1, b = unit >> 5;
    const int lane = F.lane, c = lane & 31, h = lane >> 5, hq = kvh * 8 + F.wave;
    bf16_t* QA = WSP(bf16_t, WS_QA); const bf16_t* KA = WSP(bf16_t, WS_KA); const bf16_t* VA = WSP(bf16_t, WS_VA);
    LAS unsigned char* Ks = F.lds; LAS unsigned char* Vs = F.lds + ATT_VOFF;
    const long tok0 = (long)b * SEQ + (long)(n - 1) * 128;
#pragma unroll
    for (int i = 0; i < 4; ++i) { const int piece = F.tid + 512 * i, key = piece >> 3, ch = piece & 7;
        u32x4 kv = (u32x4){0u, 0u, 0u, 0u}, vv = (u32x4){0u, 0u, 0u, 0u};
        if (n > 0 || key >= 128) { const size_t go = (size_t)(tok0 + key) * KVW + kvh * 64 + ch * 8; kv = *(const u32x4*)(KA + go); vv = *(const u32x4*)(VA + go); }
        *(LAS u32x4*)(Ks + key * ATT_KS + ch * 16) = kv; *(LAS u32x4*)(Vs + key * ATT_VS + ch * 16) = vv; }
    __syncthreads();
    const float sink2 = F.sinks[hq] * LOG2E;
    const int g2 = (lane >> 4) & 1, q4 = (lane & 15) >> 2, p4 = lane & 3;
    for (int j = 0; j < 4; ++j) {
        bf16_t* qp = QA + (size_t)(b * SEQ + n * 128 + 32 * j + c) * AW + hq * 64;
        bf16x8 qf[4];
#pragma unroll
        for (int s = 0; s < 4; ++s) qf[s] = *(const bf16x8*)(qp + 16 * s + 8 * h);
        f32x16 S[5];
#pragma unroll
        for (int t = 0; t < 5; ++t) { const int kt = j + t;
#pragma unroll
            for (int r = 0; r < 16; ++r) S[t][r] = 0.f;
#pragma unroll
            for (int s = 0; s < 4; ++s) { const bf16x8 a = *(const LAS bf16x8*)(Ks + (32 * kt + c) * ATT_KS + (16 * s + 8 * h) * 2); S[t] = mfma32(a, qf[s], S[t]); } }
        float mx = sink2;
#pragma unroll
        for (int t = 0; t < 5; ++t) { const bool tile_ok = (n > 0) || (j + t >= 4);
#pragma unroll
            for (int r = 0; r < 16; ++r) { const int row = crow(r, h); const bool ok = tile_ok && (t == 0 ? (row > c) : (t == 4 ? (row <= c) : true));
                S[t][r] = ok ? S[t][r] : -INFINITY; mx = fmaxf(mx, S[t][r]); } }
        mx = fmaxf(mx, __shfl_xor(mx, 32));
        float sum = 0.f;
#pragma unroll
        for (int t = 0; t < 5; ++t)
#pragma unroll
            for (int r = 0; r < 16; ++r) { const float p = __builtin_amdgcn_exp2f(S[t][r] - mx); S[t][r] = p; sum += p; }
        sum += __shfl_xor(sum, 32); sum += __builtin_amdgcn_exp2f(sink2 - mx);
        f32x16 O[2];
#pragma unroll
        for (int r = 0; r < 16; ++r) { O[0][r] = 0.f; O[1][r] = 0.f; }
#pragma unroll
        for (int t = 0; t < 5; ++t) { const int kt = j + t;
#pragma unroll
            for (int s = 0; s < 2; ++s) { const bf16x8 pb = acc_frag(S[t], s);
#pragma unroll
                for (int dt = 0; dt < 2; ++dt) { LAS unsigned char* vp = Vs + (32 * kt + 16 * s + 4 * h + q4) * ATT_VS + (32 * dt + 16 * g2 + 4 * p4) * 2;
                    const v4i16_t lo = tr_read(vp), hi = tr_read(vp + 8 * ATT_VS);
                    O[dt] = mfma32(cat44(lo, hi), pb, O[dt]); } } }
        const float inv = 1.0f / sum;
#pragma unroll
        for (int dt = 0; dt < 2; ++dt)
#pragma unroll
            for (int g = 0; g < 4; ++g) { u32x2 w; w.x = cvt_pk_bf16(O[dt][4 * g] * inv, O[dt][4 * g + 1] * inv); w.y = cvt_pk_bf16(O[dt][4 * g + 2] * inv, O[dt][4 * g + 3] * inv);
                *(u32x2*)(qp + 32 * dt + 8 * g + 4 * h) = w; }
    }
    __syncthreads();
}

constexpr int HG_KUT_S = 144, HG_VS_S = 320, HG_ROW_S = 272;
constexpr int HG_TOT = 0, HG_SSQ = 2048, HG_VS = 4096, HG_KUT = HG_VS + 64 * HG_VS_S, HG_QI = HG_VS + 64 * HG_VS_S, HG_QS = HG_QI + 64 * HG_ROW_S, HG_KSC = HG_QS + 64 * HG_ROW_S;
__device__ __forceinline__ void hg_cumsum(Frame& F, const bf16_t* LF, size_t base, float (&bc)[16], float& bmid, float& bL) {
    const int k = F.tid & 127, seg = F.tid >> 7;
    LAS float* tot = (LAS float*)(F.lds + HG_TOT);
    float run = 0.f;
#pragma unroll
    for (int i = 0; i < 16; ++i) { run += bf2f(LF[base + (size_t)(16 * seg + i) * HGW + k]); bc[i] = run; }
    tot[seg * 128 + k] = run;
    __syncthreads();
    const float t0 = tot[k], t1 = tot[128 + k], t2 = tot[256 + k], t3 = tot[384 + k];
    const float off = (seg > 0 ? t0 : 0.f) + (seg > 1 ? t1 : 0.f) + (seg > 2 ? t2 : 0.f);
#pragma unroll
    for (int i = 0; i < 16; ++i) bc[i] += off;
    bmid = t0 + t1; bL = (t0 + t1) + (t2 + t3);
}
__device__ __forceinline__ void hg_load_v(Frame& F, const bf16_t* IH, size_t base) {
#pragma unroll
    for (int i = 0; i < 2; ++i) { const int piece = F.tid + 512 * i, s = piece >> 4, ch = piece & 15;
        *(LAS u32x4*)(F.lds + HG_VS + s * HG_VS_S + ch * 16) = *(const u32x4*)(IH + base + (size_t)s * HGW + ch * 8); }
}
__device__ __forceinline__ void hgrn_passA_unit(Frame& F, int unit) {
    const int ch = unit & 31, bh = unit >> 5, h = bh & 7, b = bh >> 3;
    const size_t base = (size_t)(b * SEQ + 64 * ch) * HGW + h * 128;
    const int k = F.tid & 127, seg = F.tid >> 7;
    float bc[16], bmid, bL;
    hg_cumsum(F, WSP(bf16_t, WS_LF), base, bc, bmid, bL);
    const bf16_t* KH = WSP(bf16_t, WS_KH);
    float ku[16];
#pragma unroll
    for (int i = 0; i < 16; ++i) ku[i] = bf2f(KH[base + (size_t)(16 * seg + i) * HGW + k]) * __expf(bL - bc[i]);
    u32x4 w0, w1;
    w0.x = cvt_pk_bf16(ku[0], ku[1]); w0.y = cvt_pk_bf16(ku[2], ku[3]); w0.z = cvt_pk_bf16(ku[4], ku[5]); w0.w = cvt_pk_bf16(ku[6], ku[7]);
    w1.x = cvt_pk_bf16(ku[8], ku[9]); w1.y = cvt_pk_bf16(ku[10], ku[11]); w1.z = cvt_pk_bf16(ku[12], ku[13]); w1.w = cvt_pk_bf16(ku[14], ku[15]);
    *(LAS u32x4*)(F.lds + HG_KUT + k * HG_KUT_S + seg * 32) = w0; *(LAS u32x4*)(F.lds + HG_KUT + k * HG_KUT_S + seg * 32 + 16) = w1;
    if (seg == 0) WSP(float, WS_DEC)[(size_t)unit * 128 + k] = __expf(bL);
    hg_load_v(F, WSP(bf16_t, WS_IH), base);
    __syncthreads();
    const int lane = F.lane, c = lane & 31, hh = lane >> 5, g2 = (lane >> 4) & 1, q4 = (lane & 15) >> 2, p4 = lane & 3;
    const int kt = F.wave >> 1;
    f32x16 acc[2];
#pragma unroll
    for (int r = 0; r < 16; ++r) { acc[0][r] = 0.f; acc[1][r] = 0.f; }
#pragma unroll
    for (int ks = 0; ks < 4; ++ks) { const bf16x8 a = *(const LAS bf16x8*)(F.lds + HG_KUT + (32 * kt + c) * HG_KUT_S + (16 * ks + 8 * hh) * 2);
#pragma unroll
        for (int e = 0; e < 2; ++e) { const int vt = 2 * (F.wave & 1) + e; LAS unsigned char* vp = F.lds + HG_VS + (16 * ks + 8 * hh + q4) * HG_VS_S + (32 * vt + 16 * g2 + 4 * p4) * 2;
            const v4i16_t lo = tr_read(vp), hi = tr_read(vp + 4 * HG_VS_S);
            acc[e] = mfma32(a, cat44(lo, hi), acc[e]); } }
    bf16_t* US = (bf16_t*)((unsigned char*)F.out + OUT_US) + (size_t)unit * 16384;
#pragma unroll
    for (int e = 0; e < 2; ++e) { const int v = 32 * (2 * (F.wave & 1) + e) + c;
#pragma unroll
        for (int g = 0; g < 4; ++g) { u32x2 w; w.x = cvt_pk_bf16(acc[e][4 * g], acc[e][4 * g + 1]); w.y = cvt_pk_bf16(acc[e][4 * g + 2], acc[e][4 * g + 3]);
            *(u32x2*)(US + v * 128 + 32 * kt + 8 * g + 4 * hh) = w; } }
    __syncthreads();
}
__device__ __forceinline__ void hgrn_passB(Frame& F) {
    const bf16_t* __restrict__ US = (const bf16_t*)((unsigned char*)F.out + OUT_US); bf16_t* __restrict__ SS = (bf16_t*)((unsigned char*)F.out + OUT_SS);
    const float* __restrict__ DEC = WSP(float, WS_DEC);
    for (int idx = blockIdx.x * 512 + F.tid; idx < 64 * 2048; idx += F.G * 512) {
        const int bh = idx >> 11, e8 = idx & 2047, k8 = (e8 & 15) * 8;
        f32x4 s0 = (f32x4){0.f, 0.f, 0.f, 0.f}, s1 = s0;
        for (int c0 = 0; c0 < 32; c0 += 8) {
            u32x4 u[8]; f32x4 d0[8], d1[8];
#pragma unroll
            for (int i = 0; i < 8; ++i) { const size_t unit = (size_t)bh * 32 + c0 + i; u[i] = *(const u32x4*)(US + unit * 16384 + e8 * 8); d0[i] = *(const f32x4*)(DEC + unit * 128 + k8); d1[i] = *(const f32x4*)(DEC + unit * 128 + k8 + 4); }
#pragma unroll
            for (int i = 0; i < 8; ++i) { const size_t unit = (size_t)bh * 32 + c0 + i; *(u32x4*)(SS + unit * 16384 + e8 * 8) = pack8(s0, s1);
                f32x4 a, bb; unpack8(u[i], a, bb); s0 = d0[i] * s0 + a; s1 = d1[i] * s1 + bb; }
        }
    }
}
__device__ __forceinline__ void hgrn_passC_unit(Frame& F, int unit) {
    const int ch = unit & 31, bh = unit >> 5, h = bh & 7, b = bh >> 3;
    const int m0 = b * SEQ + 64 * ch;
    const size_t base = (size_t)m0 * HGW + h * 128;
    const int k = F.tid & 127, seg = F.tid >> 7;
    float bc[16], bmid, bL;
    hg_cumsum(F, WSP(bf16_t, WS_LF), base, bc, bmid, bL);
    { const bf16_t* QH = WSP(bf16_t, WS_QH); const bf16_t* KH = WSP(bf16_t, WS_KH);
#pragma unroll
      for (int i = 0; i < 16; ++i) { const int s = 16 * seg + i; const size_t go = base + (size_t)s * HGW + k;
          const float q = bf2f(QH[go]), kk = bf2f(KH[go]);
          const float eI = __expf(bc[i]), eS = __expf(bc[i] - bmid), eK = __expf(bmid - bc[i]);
          *(LAS bf16_t*)(F.lds + HG_QI + s * HG_ROW_S + k * 2) = (bf16_t)(cvt_pk_bf16(q * eI, 0.f) & 0xffffu);
          *(LAS bf16_t*)(F.lds + HG_QS + s * HG_ROW_S + k * 2) = (bf16_t)(cvt_pk_bf16(q * eS, 0.f) & 0xffffu);
          *(LAS bf16_t*)(F.lds + HG_KSC + s * HG_ROW_S + k * 2) = (bf16_t)(cvt_pk_bf16(kk * eK, 0.f) & 0xffffu); } }
    hg_load_v(F, WSP(bf16_t, WS_IH), base);
    __syncthreads();
    const int lane = F.lane, c = lane & 31, hh = lane >> 5, g2 = (lane >> 4) & 1, q4 = (lane & 15) >> 2, p4 = lane & 3;
    const int vt = F.wave & 3, tt = F.wave >> 2;
    f32x16 X[2];
#pragma unroll
    for (int st = 0; st < 2; ++st) {
#pragma unroll
        for (int r = 0; r < 16; ++r) X[st][r] = 0.f;
        if (st <= tt) {
#pragma unroll
            for (int ks = 0; ks < 8; ++ks) { const bf16x8 a = *(const LAS bf16x8*)(F.lds + HG_KSC + (32 * st + c) * HG_ROW_S + (16 * ks + 8 * hh) * 2);
                const bf16x8 bq = *(const LAS bf16x8*)(F.lds + HG_QS + (32 * tt + c) * HG_ROW_S + (16 * ks + 8 * hh) * 2); X[st] = mfma32(a, bq, X[st]); }
            if (st == tt) {
#pragma unroll
                for (int r = 0; r < 16; ++r) X[st][r] = (crow(r, hh) <= c) ? X[st][r] : 0.f; }
        }
    }
    f32x16 O;
#pragma unroll
    for (int r = 0; r < 16; ++r) O[r] = 0.f;
    const bf16_t* SS = (const bf16_t*)((unsigned char*)F.out + OUT_SS) + (size_t)unit * 16384;
#pragma unroll
    for (int ks = 0; ks < 8; ++ks) { const bf16x8 a = *(const bf16x8*)(SS + (32 * vt + c) * 128 + 16 * ks + 8 * hh);
        const bf16x8 bq = *(const LAS bf16x8*)(F.lds + HG_QI + (32 * tt + c) * HG_ROW_S + (16 * ks + 8 * hh) * 2); O = mfma32(a, bq, O); }
#pragma unroll
    for (int st = 0; st < 2; ++st) if (st <= tt) {
#pragma unroll
        for (int s2 = 0; s2 < 2; ++s2) { const bf16x8 pb = acc_frag(X[st], s2);
            LAS unsigned char* vp = F.lds + HG_VS + (32 * st + 16 * s2 + 4 * hh + q4) * HG_VS_S + (32 * vt + 16 * g2 + 4 * p4) * 2;
            const v4i16_t lo = tr_read(vp), hi = tr_read(vp + 8 * HG_VS_S);
            O = mfma32(cat44(lo, hi), pb, O); } }
    float ss = 0.f;
#pragma unroll
    for (int r = 0; r < 16; ++r) ss += O[r] * O[r];
    ss += __shfl_xor(ss, 32);
    LAS float* ssq = (LAS float*)(F.lds + HG_SSQ);
    if (hh == 0) ssq[(tt * 4 + vt) * 32 + c] = ss;
    __syncthreads();
    const float tot = (ssq[(tt * 4 + 0) * 32 + c] + ssq[(tt * 4 + 1) * 32 + c]) + (ssq[(tt * 4 + 2) * 32 + c] + ssq[(tt * 4 + 3) * 32 + c]);
    const float rstd = rsqrtf(tot * (1.0f / 128.0f) + EPS);
    bf16_t* HO = WSP(bf16_t, WS_QH); const bf16_t* GH = WSP(bf16_t, WS_GH);
    const size_t orow = (size_t)(m0 + 32 * tt + c) * HGW + h * 128;
#pragma unroll
    for (int g = 0; g < 4; ++g) { const int v0 = 32 * vt + 8 * g + 4 * hh;
        const u32x2 gw = *(const u32x2*)(GH + orow + v0); const f32x4 hn = *(const f32x4*)(F.hg_norm + v0);
        u32x2 w; w.x = cvt_pk_bf16(O[4 * g] * rstd * hn[0] * bflo(gw.x), O[4 * g + 1] * rstd * hn[1] * bfhi(gw.x));
        w.y = cvt_pk_bf16(O[4 * g + 2] * rstd * hn[2] * bflo(gw.y), O[4 * g + 3] * rstd * hn[3] * bfhi(gw.y));
        *(u32x2*)(HO + orow + v0) = w; }
    __syncthreads();
}

__device__ __forceinline__ void rows2(Frame& F) {
    const int gw = blockIdx.x * NWAVES + F.wave, NGW = F.G * NWAVES;
    const bf16_t* Y = WSP(bf16_t, WS_Y); bf16_t* H2 = WSP(bf16_t, WS_H2);
    for (int r0 = gw * 8; r0 < MTOK; r0 += NGW * 8) {
        const int b = r0 / SEQ;
        const float* mod = WSP(float, WS_MOD) + (size_t)b * NMODC;
        f32x4 g1[8], ga[8], sh[8];
#pragma unroll
        for (int j = 0; j < 8; ++j) { const int col = 4 * F.lane + 256 * j;
            g1[j] = *(const f32x4*)(mod + 2 * DM + col) * *(const f32x4*)(F.g_post_mix + col);
            ga[j] = *(const f32x4*)(F.g_pre_ffn + col) * (1.0f + *(const f32x4*)(mod + 4 * DM + col)); sh[j] = *(const f32x4*)(mod + 3 * DM + col); }
        for (int r = r0; r < r0 + 8; ++r) {
            const float* xr = F.x + (size_t)r * DM; const bf16_t* yr = Y + (size_t)r * DM;
            f32x4 v[8], y[8]; float ss = 0.f;
#pragma unroll
            for (int j = 0; j < 8; ++j) { v[j] = *(const f32x4*)(xr + 4 * F.lane + 256 * j); const u32x2 w = *(const u32x2*)(yr + 4 * F.lane + 256 * j);
                y[j] = (f32x4){bflo(w.x), bfhi(w.x), bflo(w.y), bfhi(w.y)}; ss += (y[j][0] * y[j][0] + y[j][1] * y[j][1]) + (y[j][2] * y[j][2] + y[j][3] * y[j][3]); }
            const float rstd = rsqrtf(wave_sum(ss) * (1.0f / DM) + EPS);
            float s2 = 0.f; float* orow = F.out + (size_t)r * DM;
#pragma unroll
            for (int j = 0; j < 8; ++j) { v[j] = v[j] + g1[j] * (y[j] * rstd); *(f32x4*)(orow + 4 * F.lane + 256 * j) = v[j];
                s2 += (v[j][0] * v[j][0] + v[j][1] * v[j][1]) + (v[j][2] * v[j][2] + v[j][3] * v[j][3]); }
            const float rstd2 = rsqrtf(wave_sum(s2) * (1.0f / DM) + EPS);
            bf16_t* hrow = H2 + (size_t)r * DM;
#pragma unroll
            for (int j = 0; j < 8; ++j) { const f32x4 h = v[j] * rstd2 * ga[j] + sh[j]; u32x2 w; w.x = cvt_pk_bf16(h[0], h[1]); w.y = cvt_pk_bf16(h[2], h[3]); *(u32x2*)(hrow + 4 * F.lane + 256 * j) = w; }
        }
    }
}
__device__ __forceinline__ void rows3(Frame& F) {
    const int gw = blockIdx.x * NWAVES + F.wave, NGW = F.G * NWAVES;
    const bf16_t* Y2 = WSP(bf16_t, WS_Y2);
    for (int r0 = gw * 8; r0 < MTOK; r0 += NGW * 8) {
        const int b = r0 / SEQ;
        const float* mod = WSP(float, WS_MOD) + (size_t)b * NMODC;
        f32x4 g2[8];
#pragma unroll
        for (int j = 0; j < 8; ++j) { const int col = 4 * F.lane + 256 * j; g2[j] = *(const f32x4*)(mod + 5 * DM + col) * *(const f32x4*)(F.g_post_ffn + col); }
        for (int r = r0; r < r0 + 8; ++r) {
            float* orow = F.out + (size_t)r * DM; const bf16_t* yr = Y2 + (size_t)r * DM;
            f32x4 v[8], y[8]; float ss = 0.f;
#pragma unroll
            for (int j = 0; j < 8; ++j) { v[j] = *(const f32x4*)(orow + 4 * F.lane + 256 * j); const u32x2 w = *(const u32x2*)(yr + 4 * F.lane + 256 * j);
                y[j] = (f32x4){bflo(w.x), bfhi(w.x), bflo(w.y), bfhi(w.y)}; ss += (y[j][0] * y[j][0] + y[j][1] * y[j][1]) + (y[j][2] * y[j][2] + y[j][3] * y[j][3]); }
            const float rstd = rsqrtf(wave_sum(ss) * (1.0f / DM) + EPS);
#pragma unroll
            for (int j = 0; j < 8; ++j) *(f32x4*)(orow + 4 * F.lane + 256 * j) = v[j] + g2[j] * (y[j] * rstd);
        }
    }
}

constexpr int NPH = 12;
struct Args { const void* in[18]; float* out; unsigned char* ws; int ph_lo, ph_hi; };
__global__ void __launch_bounds__(NWAVES * 64, 2) fwd_kernel(Args args) {
    extern __shared__ __attribute__((aligned(16))) unsigned char lds_raw[];
    Frame F;
    F.lds = (LAS unsigned char*)lds_raw;
    F.tid = threadIdx.x; F.lane = F.tid & 63; F.wave = __builtin_amdgcn_readfirstlane(F.tid >> 6);
    F.G = gridDim.x; { const int bx = blockIdx.x; F.vcu = (F.G % 8 == 0) ? (bx % 8) * (F.G / 8) + bx / 8 : bx; }
    F.x = (const float*)args.in[0]; F.c = (const float*)args.in[1]; F.positions = (const int*)args.in[2]; F.w_ada = (const float*)args.in[3]; F.b_ada = (const float*)args.in[4];
    F.g_pre_mix = (const float*)args.in[5]; F.g_post_mix = (const float*)args.in[6]; F.g_pre_ffn = (const float*)args.in[7]; F.g_post_ffn = (const float*)args.in[8];
    F.w_in = (const float*)args.in[9]; F.sinks = (const float*)args.in[10]; F.w_ap = (const float*)args.in[11]; F.hg_lb = (const float*)args.in[12]; F.hg_norm = (const float*)args.in[13];
    F.w_hp = (const float*)args.in[14]; F.w_out = (const float*)args.in[15]; F.w_fi = (const float*)args.in[16]; F.w_fo = (const float*)args.in[17];
    F.out = args.out; F.ws = args.ws;
    volatile LAS unsigned* MISC = (volatile LAS unsigned*)(F.lds + MISC_OFF);
    for (int u = F.tid; u < (LDS_BYTES - LDSCTL_OFF) / 4; u += NWAVES * 64) ((LAS unsigned*)(F.lds + LDSCTL_OFF))[u] = 0u;
    __syncthreads();
    const int lo = args.ph_lo, hi = args.ph_hi;
    XcdBarrier bar; bar.bar = WSP(unsigned, WS_CTL) + CW_BAR; bar.x = 0; bar.st = nullptr;
    if (hi - lo > 1) bar = xcd_barrier_post(WSP(unsigned, WS_CTL) + CW_BAR, MISC + 8);
#define IN(k) (lo <= (k) && (k) < hi)
#define REP(k) for (int rep_ = 0; rep_ < ((k) == PROBE_DOUBLE ? 2 : 1); ++rep_)
#define SEAM(k) do { if (IN(k) && IN((k) + 1)) xcd_barrier(bar); } while (0)

    if (IN(0)) { REP(0) { p0_prologue(F); if (PROBE_DOUBLE == 0) xcd_barrier(bar); } SEAM(0); }
    if (IN(1)) { p1_rows(F); SEAM(1); }
    if (IN(2)) REP(2) {
        pg8::SingleOrder S; S.so.init(MTOK, INC, F.G, (int)blockIdx.x); S.A = (const char*)F.out + OUT_XN; S.B = (const char*)(F.ws + WS_WIN); S.tstep = (size_t)256 * DM * 2;
        EpiG1 E{F.ws, WSP(float, WS_ROPE), WSP(float, WS_LB)};
        pg8::gemm_phase<EpiG1, pg8::SingleOrder, true, true>(F.lds, DM, S, E);
        SEAM(2);
    }
    if (IN(3)) {
#if NAIVE_HGRN
        hgrn_naive_scan(F);
#endif
#if NAIVE_ATTN
        attn_naive(F);
#else
        for (int u = blockIdx.x; u < NB * 2 * 16; u += F.G) attn_unit(F, u);
#endif
#if !NAIVE_HGRN
        REP(3) for (int u = blockIdx.x; u < 2048; u += F.G) hgrn_passA_unit(F, u);
#endif
        SEAM(3);
    }
    if (IN(4)) {
#if NAIVE_HGRN
        hgrn_naive_finish(F);
#else
        REP(4) hgrn_passB(F);
#endif
        SEAM(4);
    }
    if (IN(5)) {
#if !NAIVE_HGRN
        for (int u = blockIdx.x; u < 2048; u += F.G) hgrn_passC_unit(F, u);
#endif
        SEAM(5);
    }
    if (IN(6)) {
        pg8::DualOrder S; S.so.init(MTOK, DM, F.G, (int)blockIdx.x); S.A0 = (const char*)(F.ws + WS_QA); S.B0 = (const char*)(F.ws + WS_WAP); S.A1 = (const char*)(F.ws + WS_QH); S.B1 = (const char*)(F.ws + WS_WHP); S.tstep = (size_t)256 * AW * 2;
        EpiMerge E{WSP(bf16_t, WS_GA), WSP(bf16_t, WS_GHT), WSP(bf16_t, WS_MERGED)};
        pg8::gemm_phase<EpiMerge, pg8::DualOrder, true, true>(F.lds, AW, S, E);
        SEAM(6);
    }
    if (IN(7)) {
        pg8::SingleOrder S; S.so.init(MTOK, DM, F.G, (int)blockIdx.x); S.A = (const char*)(F.ws + WS_MERGED); S.B = (const char*)(F.ws + WS_WOUT); S.tstep = (size_t)256 * DM * 2;
        EpiPlain E{WSP(bf16_t, WS_Y), DM};
        pg8::gemm_phase<EpiPlain, pg8::SingleOrder, true, true>(F.lds, DM, S, E);
        SEAM(7);
    }
    if (IN(8)) { REP(8) rows2(F); SEAM(8); }
    if (IN(9)) REP(9) {
        pg8::SingleOrder S; S.so.init(MTOK, 2 * FFH, F.G, (int)blockIdx.x); S.A = (const char*)(F.ws + WS_H2); S.B = (const char*)(F.ws + WS_WFI); S.tstep = (size_t)256 * DM * 2;
        EpiSwiGLU E{WSP(bf16_t, WS_ACT)};
        pg8::gemm_phase<EpiSwiGLU, pg8::SingleOrder, true, true>(F.lds, DM, S, E);
        SEAM(9);
    }
    if (IN(10)) {
        pg8::SingleOrder S; S.so.init(MTOK, DM, F.G, (int)blockIdx.x); S.A = (const char*)(F.ws + WS_ACT); S.B = (const char*)(F.ws + WS_WFO); S.tstep = (size_t)256 * FFH * 2;
        EpiPlain E{WSP(bf16_t, WS_Y2), DM};
        pg8::gemm_phase<EpiPlain, pg8::SingleOrder, true, true>(F.lds, FFH, S, E);
        SEAM(10);
    }
    if (IN(11)) { rows3(F); }
#undef IN
#undef SEAM
}

extern "C" void kernel_launch(void* const* d_in, const int* in_sizes, int n_in, void* d_out, int out_size, void* d_ws, size_t ws_size, hipStream_t stream) {
    static int grid = 0;
    if (grid == 0) {
        if (n_in != 18 || in_sizes[0] != MTOK * DM || out_size != MTOK * DM || ws_size < WS_END) { fprintf(stderr, "kernel_launch: unexpected shapes (n_in %d, out %d, ws %zu); nothing launched\n", n_in, out_size, ws_size); grid = -1; return; }
        int dev = 0, cus = 0, per_cu = 0;
        if (hipGetDevice(&dev) != hipSuccess || hipDeviceGetAttribute(&cus, hipDeviceAttributeMultiprocessorCount, dev) != hipSuccess) { grid = -1; return; }
        if (hipFuncSetAttribute((const void*)fwd_kernel, hipFuncAttributeMaxDynamicSharedMemorySize, LDS_BYTES) != hipSuccess) { fprintf(stderr, "kernel_launch: hipFuncSetAttribute failed\n"); grid = -1; return; }
        if (hipOccupancyMaxActiveBlocksPerMultiprocessor(&per_cu, (const void*)fwd_kernel, NWAVES * 64, LDS_BYTES) != hipSuccess || per_cu < 1) { fprintf(stderr, "kernel_launch: occupancy query says %d blocks per CU\n", per_cu); (void)hipGetLastError(); grid = -1; return; }
        grid = cus;
    }
    if (grid < 0) return;
    (void)hipMemsetAsync((char*)d_ws + WS_CTL, 0, CTL_ZERO_BYTES, stream);
    Args a{};
    for (int i = 0; i < 18; ++i) a.in[i] = d_in[i];
    a.out = (float*)d_out; a.ws = (unsigned char*)d_ws;
    if (MK_N_LAUNCHES == 1) { a.ph_lo = 0; a.ph_hi = NPH; hipLaunchKernelGGL(fwd_kernel, dim3(grid), dim3(NWAVES * 64), LDS_BYTES, stream, a); }
    else for (int p = 0; p < NPH; ++p) { a.ph_lo = p; a.ph_hi = p + 1; hipLaunchKernelGGL(fwd_kernel, dim3(grid), dim3(NWAVES * 64), LDS_BYTES, stream, a); }
}
```

```cpp
#include <hip/hip_runtime.h>
#include <cstdio>
#include <cstdint>

#ifndef MK_N_LAUNCHES
#define MK_N_LAUNCHES 1
#endif

#ifndef PROBE_MASK
#define PROBE_MASK 0
#endif
#ifndef PROBE_DOUBLE
#define PROBE_DOUBLE -1
#endif
#ifndef NAIVE_ATTN
#define NAIVE_ATTN 0
#endif
#ifndef NAIVE_HGRN
#define NAIVE_HGRN 0
#endif

#define LAS __attribute__((address_space(3)))
#define GAS __attribute__((address_space(1)))
typedef unsigned short bf16_t;
typedef short bf16x8 __attribute__((ext_vector_type(8)));
typedef float f32x4 __attribute__((ext_vector_type(4)));
typedef float f32x2 __attribute__((ext_vector_type(2)));
typedef unsigned u32x4 __attribute__((ext_vector_type(4)));
typedef unsigned u32x2 __attribute__((ext_vector_type(2)));
typedef float f32x16 __attribute__((ext_vector_type(16)));
typedef short v4i16_t __attribute__((ext_vector_type(4)));

constexpr int NWAVES = 8;
constexpr int NB = 8, SEQ = 2048, DM = 2048, MTOK = NB * SEQ;
constexpr int AW = 1024, KVW = 128, HGW = 1024, FFH = 5632, INC = 9472, NMODC = 6 * DM;
constexpr float EPS = 1e-6f;
constexpr float LOG2E = 1.4426950408889634f;
constexpr float QSCALE = 0.125f * 1.4426950408889634f;

typedef __bf16 bf16x2_t __attribute__((ext_vector_type(2)));
__device__ __forceinline__ unsigned cvt_pk_bf16(float lo, float hi) { const f32x2 v = {lo, hi}; const bf16x2_t b = __builtin_convertvector(v, bf16x2_t); return __builtin_bit_cast(unsigned, b); }
__device__ __forceinline__ float bflo(unsigned w) { return __uint_as_float(w << 16); }
__device__ __forceinline__ float bfhi(unsigned w) { return __uint_as_float(w & 0xffff0000u); }
__device__ __forceinline__ float bf2f(bf16_t h) { return __uint_as_float((unsigned)h << 16); }
__device__ __forceinline__ float frcp(float x) { return __builtin_amdgcn_rcpf(x); }
__device__ __forceinline__ float fsigmoid(float x) { return frcp(1.0f + __expf(-x)); }
__device__ __forceinline__ u32x4 pack8(f32x4 a, f32x4 b) { u32x4 w; w.x = cvt_pk_bf16(a[0], a[1]); w.y = cvt_pk_bf16(a[2], a[3]); w.z = cvt_pk_bf16(b[0], b[1]); w.w = cvt_pk_bf16(b[2], b[3]); return w; }
__device__ __forceinline__ void unpack8(u32x4 w, f32x4& a, f32x4& b) { a = (f32x4){bflo(w.x), bfhi(w.x), bflo(w.y), bfhi(w.y)}; b = (f32x4){bflo(w.z), bfhi(w.z), bflo(w.w), bfhi(w.w)}; }

namespace pg8 {
constexpr int BM = 256, BK = 64, HALF = 128, HTB = HALF * BK * 2  , STAGE_BYTES = 8 * HTB, NXCD = 8, WGM = 8;

__host__ __device__ __forceinline__ int lds_byte(int r, int c) { const int st = (r >> 4) * 2 + (c >> 5), rr = r & 15, cc = c & 31, ob = rr * 64 + cc * 2; return st * 1024 + (ob ^ (((ob >> 9) & 1) << 5)); }
__host__ __device__ __forceinline__ void stage_rc(int b, int& R, int& C) { const int st = b / 1024, sb = b % 1024, swz = sb ^ (((sb >> 9) & 1) << 5); R = (st >> 1) * 16 + swz / 64; C = (st & 1) * 32 + (swz % 64) / 2; }
__host__ __device__ __forceinline__ int perm32(int rho) { const int n = rho >> 4, i = rho & 15; return 8 * (i >> 2) + 4 * n + (i & 3); }

struct Unit { int pm, pn, sub; };

struct StaticOrder {
    int nM, nN, nwg, G, c;
    __host__ __device__ void init(int M, int N, int G_, int c_) { nM = M / BM; nN = N / BM; nwg = nM * nN; G = G_; c = c_; }
    __host__ __device__ bool next(int i, Unit& u) const {
        const long L = (long)i * G + c; if (L >= nwg) return false;
        int wgid = (int)L; { const int q = nwg / NXCD, r = nwg % NXCD, xcd = wgid % NXCD, off = wgid / NXCD; wgid = (xcd < r ? xcd * (q + 1) : r * (q + 1) + (xcd - r) * q) + off; }
        const int nig = WGM * nN, gid = wgid / nig, fm = gid * WGM, gsz = (nM - fm) < WGM ? (nM - fm) : WGM;
        u.pm = fm + ((wgid % nig) % gsz); u.pn = (wgid % nig) / gsz; u.sub = 0; return true;
    }
};
struct SingleOrder {
    StaticOrder so; const char* A; const char* B; size_t tstep;
    __device__ __forceinline__ bool next(int i, Unit& u) const { return so.next(i, u); }
    __device__ __forceinline__ const char* aptr(const Unit& u) const { return A + (size_t)u.pm * tstep; }
    __device__ __forceinline__ const char* bptr(const Unit& u) const { return B + (size_t)u.pn * tstep; }
};
struct DualOrder {
    StaticOrder so; const char *A0, *B0, *A1, *B1; size_t tstep;
    __device__ __forceinline__ bool next(int i, Unit& u) const { if (!so.next(i >> 1, u)) return false; u.sub = i & 1; return true; }
    __device__ __forceinline__ const char* aptr(const Unit& u) const { return (u.sub ? A1 : A0) + (size_t)u.pm * tstep; }
    __device__ __forceinline__ const char* bptr(const Unit& u) const { return (u.sub ? B1 : B0) + (size_t)u.pn * tstep; }
};

typedef f32x4 Acc[2][2][4][2];

template <class Epi, class Sched, bool ALIGN_EPI, bool SP2>
__device__ __forceinline__ void gemm_phase(LAS unsigned char* lds, const int K, const Sched& S, const Epi& E) {
    const int tid = threadIdx.x, wid = __builtin_amdgcn_readfirstlane(tid >> 6), lane = tid & 63, wr = wid >> 2, wc = wid & 3, fr = lane & 15, fq = lane >> 4;
    const int nt = K / BK;
    unsigned voffA[2], voffB[2];
#pragma unroll
    for (int i = 0; i < 2; ++i) { int R, C; stage_rc(tid * 16 + i * 8192, R, C); const int Rb = ((R & ~31) + perm32(R & 31));
        voffA[i] = (unsigned)(R * K + C) * 2u; voffB[i] = (unsigned)(Rb * K + C) * 2u; }
    const size_t kstep = (size_t)(BK * 2);
    const size_t hstep = (size_t)HALF * K * 2;
    const unsigned ldsw = (unsigned)wid * 1024u;
    const int aoff = lds_byte(wr * 64 + fr, fq * 8), boff = lds_byte(wc * 32 + fr, fq * 8);
#define PG8_SA(b, h) (((b) * 2 + (h)) * HTB)
#define PG8_SB(b, h) ((4 + (b) * 2 + (h)) * HTB)
#define PG8_STAGE(bufoff, gbase, voff) do { _Pragma("unroll") for (int _i = 0; _i < 2; ++_i) \
        __builtin_amdgcn_global_load_lds((const unsigned*)((const char*)(gbase) + (voff)[_i]), (LAS unsigned*)(lds + (bufoff) + ldsw + _i * 8192), 16, 0, 0); } while (0)
#define PG8_LDA(dst, b, h) do { _Pragma("unroll") for (int m = 0; m < 4; ++m) _Pragma("unroll") for (int k = 0; k < 2; ++k) dst[m][k] = *(const LAS bf16x8*)(lds + PG8_SA(b, h) + aoff + m * 2048 + k * 1024); } while (0)
#define PG8_LDB(dst, b, h) do { _Pragma("unroll") for (int n = 0; n < 2; ++n) _Pragma("unroll") for (int k = 0; k < 2; ++k) dst[n][k] = *(const LAS bf16x8*)(lds + PG8_SB(b, h) + boff + n * 2048 + k * 1024); } while (0)
#define PG8_MMA(ai, bj, At, Bt) do { __builtin_amdgcn_s_setprio(1); _Pragma("unroll") for (int m = 0; m < 4; ++m) _Pragma("unroll") for (int n = 0; n < 2; ++n) _Pragma("unroll") for (int k = 0; k < 2; ++k) \
        acc[ai][bj][m][n] = __builtin_amdgcn_mfma_f32_16x16x32_bf16(Bt[n][k], At[m][k], acc[ai][bj][m][n], 0, 0, 0); __builtin_amdgcn_s_setprio(0); } while (0)
#define PG8_WAIT_V(n) asm volatile("s_waitcnt vmcnt(" #n ")" ::: "memory")
#define PG8_WAIT_L(n) asm volatile("s_waitcnt lgkmcnt(" #n ")" ::: "memory")
#define PG8_BAR __builtin_amdgcn_s_barrier()
#define PG8_SCHED __builtin_amdgcn_sched_barrier(0)
    Unit cur, nxt; int ui = 0;
    if (!S.next(0, cur)) return;
    Acc acc;
#pragma unroll
    for (int a = 0; a < 2; ++a)
#pragma unroll
        for (int b = 0; b < 2; ++b)
#pragma unroll
            for (int m = 0; m < 4; ++m)
#pragma unroll
                for (int n = 0; n < 2; ++n) acc[a][b][m][n] = (f32x4){0.f, 0.f, 0.f, 0.f};
    bf16x8 At[4][2], B0[2][2], B1[2][2];
    const char* cA = S.aptr(cur); const char* cB = S.bptr(cur);
    if constexpr (SP2) {
        PG8_STAGE(PG8_SB(0, 0), cB, voffB); PG8_STAGE(PG8_SB(0, 1), cB + hstep, voffB); PG8_STAGE(PG8_SA(0, 0), cA, voffA); PG8_STAGE(PG8_SA(0, 1), cA + hstep, voffA);
        if (wr == 1) PG8_BAR;
        PG8_WAIT_V(2); PG8_BAR;
        PG8_STAGE(PG8_SB(1, 0), cB + kstep, voffB); PG8_STAGE(PG8_SA(1, 0), cA + kstep, voffA); PG8_STAGE(PG8_SB(1, 1), cB + hstep + kstep, voffB);
        PG8_WAIT_V(6); PG8_BAR;
    } else {
        PG8_STAGE(PG8_SB(0, 0), cB, voffB); PG8_STAGE(PG8_SA(0, 0), cA, voffA); PG8_STAGE(PG8_SB(0, 1), cB + hstep, voffB); PG8_STAGE(PG8_SA(0, 1), cA + hstep, voffA);
        if (wr == 1) PG8_BAR;
        PG8_WAIT_V(4); PG8_BAR;
        PG8_STAGE(PG8_SB(1, 0), cB + kstep, voffB); PG8_STAGE(PG8_SA(1, 0), cA + kstep, voffA); PG8_STAGE(PG8_SB(1, 1), cB + hstep + kstep, voffB);
        PG8_WAIT_V(6); PG8_BAR;
    }
    for (;;) {
        const bool has_next = S.next(ui + 1, nxt);
        const char* nA = has_next ? S.aptr(nxt) : cA; const char* nB = has_next ? S.bptr(nxt) : cB;
        for (int t = 0; t < nt; t += 2) {
            const bool last = (t == nt - 2);
            const char* a1 = cA + (size_t)(t + 1) * kstep;
            const char* a2 = last ? nA : cA + (size_t)(t + 2) * kstep; const char* b2 = last ? nB : cB + (size_t)(t + 2) * kstep;
            const char* a3 = a2 + kstep; const char* b3 = b2 + kstep;
            if constexpr (SP2) {
            PG8_LDB(B0, 0, 0); PG8_LDB(B1, 0, 1); PG8_SCHED; PG8_LDA(At, 0, 0); PG8_STAGE(PG8_SA(1, 1), a1 + hstep, voffA);
            PG8_WAIT_V(8); PG8_WAIT_L(0); PG8_BAR; PG8_MMA(0, 0, At, B0); PG8_MMA(0, 1, At, B1); PG8_BAR; PG8_SCHED;
            PG8_LDA(At, 0, 1); PG8_STAGE(PG8_SB(0, 0), b2, voffB); PG8_STAGE(PG8_SB(0, 1), b2 + hstep, voffB); PG8_STAGE(PG8_SA(0, 0), a2, voffA);
            PG8_WAIT_V(8); PG8_WAIT_L(0); PG8_BAR; PG8_MMA(1, 0, At, B0); PG8_MMA(1, 1, At, B1); PG8_BAR; PG8_SCHED;
            PG8_LDB(B0, 1, 0); PG8_LDB(B1, 1, 1); PG8_SCHED; PG8_LDA(At, 1, 0); PG8_STAGE(PG8_SA(0, 1), a2 + hstep, voffA);
            PG8_WAIT_V(8); PG8_WAIT_L(0); PG8_BAR; PG8_MMA(0, 0, At, B0); PG8_MMA(0, 1, At, B1); PG8_BAR; PG8_SCHED;
            PG8_LDA(At, 1, 1); PG8_STAGE(PG8_SB(1, 0), b3, voffB); PG8_STAGE(PG8_SB(1, 1), b3 + hstep, voffB); PG8_STAGE(PG8_SA(1, 0), a3, voffA);
            PG8_WAIT_V(8); PG8_WAIT_L(0); PG8_BAR; PG8_MMA(1, 0, At, B0); PG8_MMA(1, 1, At, B1); PG8_BAR; PG8_SCHED;
            } else {
            PG8_LDB(B0, 0, 0); PG8_SCHED; PG8_LDA(At, 0, 0); PG8_STAGE(PG8_SA(1, 1), a1 + hstep, voffA);
            PG8_WAIT_L(8); PG8_BAR; PG8_WAIT_L(0); PG8_MMA(0, 0, At, B0); PG8_BAR; PG8_SCHED;
            PG8_LDB(B1, 0, 1); PG8_STAGE(PG8_SB(0, 0), b2, voffB);
            PG8_BAR; PG8_WAIT_L(0); PG8_MMA(0, 1, At, B1); PG8_BAR;
            PG8_LDA(At, 0, 1); PG8_STAGE(PG8_SA(0, 0), a2, voffA);
            PG8_BAR; PG8_WAIT_L(0); PG8_MMA(1, 0, At, B0); PG8_BAR; PG8_SCHED;
            PG8_STAGE(PG8_SB(0, 1), b2 + hstep, voffB);
            PG8_WAIT_V(6); PG8_BAR; PG8_MMA(1, 1, At, B1); PG8_BAR;
            PG8_LDB(B0, 1, 0); PG8_SCHED; PG8_LDA(At, 1, 0); PG8_STAGE(PG8_SA(0, 1), a2 + hstep, voffA);
            PG8_WAIT_L(8); PG8_BAR; PG8_WAIT_L(0); PG8_MMA(0, 0, At, B0); PG8_BAR; PG8_SCHED;
            PG8_LDB(B1, 1, 1); PG8_STAGE(PG8_SB(1, 0), b3, voffB);
            PG8_BAR; PG8_WAIT_L(0); PG8_MMA(0, 1, At, B1); PG8_BAR;
            PG8_LDA(At, 1, 1); PG8_STAGE(PG8_SA(1, 0), a3, voffA);
            PG8_BAR; PG8_WAIT_L(0); PG8_MMA(1, 0, At, B0); PG8_BAR; PG8_SCHED;
            PG8_STAGE(PG8_SB(1, 1), b3 + hstep, voffB);
            PG8_WAIT_V(6); PG8_BAR; PG8_MMA(1, 1, At, B1); PG8_BAR;
            }
        }
        if constexpr (ALIGN_EPI) { if (wr == 0) PG8_BAR; }
        E(acc, cur, wr, wc, fr, fq);
        if (!has_next) break;
        if (!Epi::keep_acc(cur)) {
#pragma unroll
        for (int a = 0; a < 2; ++a)
#pragma unroll
            for (int b = 0; b < 2; ++b)
#pragma unroll
                for (int m = 0; m < 4; ++m)
#pragma unroll
                    for (int n = 0; n < 2; ++n) acc[a][b][m][n] = (f32x4){0.f, 0.f, 0.f, 0.f};
        }
        cur = nxt; cA = nA; cB = nB; ++ui;
        if constexpr (ALIGN_EPI) { if (wr == 1) PG8_BAR; }
    }
    PG8_WAIT_V(0);
    if constexpr (!ALIGN_EPI) { if (wr == 0) PG8_BAR; }
    PG8_BAR;
#undef PG8_SA
#undef PG8_SB
#undef PG8_STAGE
#undef PG8_LDA
#undef PG8_LDB
#undef PG8_MMA
#undef PG8_WAIT_V
#undef PG8_WAIT_L
#undef PG8_BAR
#undef PG8_SCHED
}
}

constexpr size_t MiB = 1u << 20;
constexpr size_t WS_CTL = 0, CTL_ZERO_BYTES = 64 * 1024;
constexpr size_t WS_MOD = 1 * MiB;
constexpr size_t WS_LB = 1 * MiB + 512 * 1024;
constexpr size_t WS_ROPE = 2 * MiB;
constexpr size_t WS_DEC = 3 * MiB;
constexpr size_t WS_WIN = 4 * MiB, WS_WAP = 41 * MiB, WS_WHP = 45 * MiB, WS_WOUT = 49 * MiB, WS_WFI = 57 * MiB, WS_WFO = 101 * MiB;
constexpr size_t WS_QA = 128 * MiB, WS_QH = 160 * MiB, WS_KH = 192 * MiB, WS_LF = 224 * MiB, WS_IH = 256 * MiB, WS_GH = 288 * MiB;
constexpr size_t WS_KA = 320 * MiB, WS_VA = 324 * MiB, WS_GA = 328 * MiB, WS_GHT = 392 * MiB;
constexpr size_t WS_MERGED = 192 * MiB;
constexpr size_t WS_Y = 128 * MiB;
constexpr size_t WS_H2 = 256 * MiB;
constexpr size_t WS_ACT = 328 * MiB;
constexpr size_t WS_Y2 = 128 * MiB;
constexpr size_t WS_END = 504 * MiB;
constexpr size_t OUT_XN = 0, OUT_ORAW = 0, OUT_US = 64 * MiB, OUT_SS = 0;

constexpr int CW_BAR = 4096;

constexpr int RING_BYTES = 131072;
constexpr int LDSCTL_OFF = RING_BYTES, MISC_OFF = LDSCTL_OFF + 320;
constexpr int LDS_BYTES = 147456;

#define RLX_AGENT __ATOMIC_RELAXED, __HIP_MEMORY_SCOPE_AGENT
#define LDS_WAIT() asm volatile("s_waitcnt lgkmcnt(0)" ::: "memory")

#define XB_TMO      128
#define XB_XCNT(j)  (256  + 64 * (j))
#define XB_XSUB(j)  (1280 + 64 * (j))
#define XB_XGEN(j)  (2304 + 64 * (j))
#define XB_TOP      3328
#define XB_TOPGEN   3392
#define XCD_BAR_WORDS 3456
#define XB_SPIN_CAP (1u << 22)

__device__ __forceinline__ unsigned xb_ld(unsigned* p)              { return __hip_atomic_load(p, __ATOMIC_RELAXED, __HIP_MEMORY_SCOPE_AGENT); }
__device__ __forceinline__ unsigned xb_add(unsigned* p, unsigned v) { return __hip_atomic_fetch_add(p, v, __ATOMIC_RELAXED, __HIP_MEMORY_SCOPE_AGENT); }
__device__ __forceinline__ unsigned xb_xcc_id() { return (unsigned)__builtin_amdgcn_s_getreg((3 << 11) | 20) & 0xFu; }
#define XB_SPIN(cond, bar) do { unsigned _sp = 0; while (cond) { __builtin_amdgcn_s_sleep(1); \
    if ((++_sp & 255u) == 0u) { if (xb_ld(&(bar)[XB_TMO])) break; if (_sp > XB_SPIN_CAP) { atomicAdd(&(bar)[XB_TMO], 1u); break; } } } } while (0)

struct XcdBarrier { unsigned* bar; unsigned x; volatile LAS unsigned* st; };

__device__ __forceinline__ XcdBarrier xcd_barrier_post(unsigned* bar, volatile LAS unsigned* st) {
    XcdBarrier b; b.bar = bar; b.x = xb_xcc_id(); b.st = st;
    if (threadIdx.x == 0) (void)xb_add(&bar[XB_XCNT(b.x)], 1u);
    return b;
}
__device__ __forceinline__ void xcd_barrier_complete(unsigned* bar, unsigned x, unsigned& nloc, unsigned& nx) {
    const unsigned G = gridDim.x * gridDim.y * gridDim.z;
    unsigned sum, cnt, mine, sp = 0u;
    for (;;) {
        sum = 0u; cnt = 0u; mine = 0u;
#pragma unroll
        for (unsigned j = 0; j < 16; ++j) { const unsigned c = xb_ld(&bar[XB_XCNT(j)]); sum += c; cnt += (c > 0u) ? 1u : 0u; mine = (j == x) ? c : mine; }
        if (sum == G) break;
        __builtin_amdgcn_s_sleep(1);
        if ((++sp & 255u) == 0u) { if (xb_ld(&bar[XB_TMO])) break; if (sp > XB_SPIN_CAP) { atomicAdd(&bar[XB_TMO], 1u); break; } }
    }
    nloc = mine > 0u ? mine : 1u; nx = cnt > 0u ? cnt : 1u;
}
__device__ __forceinline__ void xcd_barrier(const XcdBarrier& b) {
    asm volatile("s_waitcnt vmcnt(0)" ::: "memory");
    __syncthreads();
    if (threadIdx.x == 0) {
        unsigned* bar = b.bar;
        __builtin_amdgcn_s_waitcnt(0);
        unsigned nloc = b.st[0], nx = b.st[1];
        if (nloc == 0u) { xcd_barrier_complete(bar, b.x, nloc, nx); b.st[0] = nloc; b.st[1] = nx; }
        const unsigned old = xb_add(&bar[XB_XSUB(b.x)], 1u);
        const unsigned gen = old / nloc;
        if (old + 1u == (gen + 1u) * nloc) {
            __builtin_amdgcn_fence(__ATOMIC_RELEASE, "agent");
            asm volatile("s_waitcnt vmcnt(0)" ::: "memory");
            const unsigned og = xb_add(&bar[XB_TOP], 1u);
            const unsigned tg = og / nx;
            if (og + 1u == (tg + 1u) * nx) xb_add(&bar[XB_TOPGEN], 1u);
            else XB_SPIN(xb_ld(&bar[XB_TOPGEN]) == tg, bar);
            __builtin_amdgcn_fence(__ATOMIC_ACQUIRE, "agent");
            xb_add(&bar[XB_XGEN(b.x)], 1u);
            asm volatile("s_waitcnt vmcnt(0)" ::: "memory");
        } else {
            XB_SPIN(xb_ld(&bar[XB_XGEN(b.x)]) == gen, bar);
            __builtin_amdgcn_fence(__ATOMIC_ACQUIRE, "agent");
            asm volatile("s_waitcnt vmcnt(0)" ::: "memory");
        }
    }
    __syncthreads();
}

struct Frame {
    LAS unsigned char* lds;
    int tid, lane, wave, vcu, G;
    const float *x, *c, *w_ada, *b_ada, *g_pre_mix, *g_post_mix, *g_pre_ffn, *g_post_ffn, *w_in, *sinks, *w_ap, *hg_lb, *hg_norm, *w_hp, *w_out, *w_fi, *w_fo;
    const int* positions;
    float* out;
    unsigned char* ws;
};
#define WSP(T, off) ((T*)(F.ws + (off)))

__device__ __forceinline__ float wave_sum(float v) {
#pragma unroll
    for (int o = 1; o < 64; o <<= 1) v += __shfl_xor(v, o);
    return v;
}

__device__ __forceinline__ int win_dst(int n) {
    if (n < AW + KVW) { int p = n & 63; if (p >= 4 && p < 12) p = (p < 8) ? p + 4 : p - 4; return (n & ~63) + p; }
    return n;
}
__device__ __forceinline__ int wfi_dst(int n) {
    if (n < FFH) return 256 * (n >> 7) + (n & 127);
    n -= FFH; return 256 * (n >> 7) + 128 + (n & 127);
}
template <int MODE>
__device__ __forceinline__ void p0_conv_item(const float* __restrict__ W, int K, int N, bf16_t* __restrict__ WT, int item, int lane) {
    const int nblk = N >> 7, kb = item / nblk, nb = item - kb * nblk;
    const int k0 = 64 * kb + 32 * (lane >> 5), n = 128 * nb + 4 * (lane & 31);
    const float* src = W + (size_t)k0 * N + n;
    size_t rows[4];
#pragma unroll
    for (int e = 0; e < 4; ++e) { const int nn = n + e; rows[e] = (size_t)((MODE == 1) ? win_dst(nn) : (MODE == 2) ? wfi_dst(nn) : nn) * K + k0; }
#pragma unroll
    for (int half = 0; half < 2; ++half) {
        f32x4 v[16];
#pragma unroll
        for (int i = 0; i < 16; ++i) v[i] = __builtin_nontemporal_load((const f32x4*)(src + (size_t)(16 * half + i) * N));
#pragma unroll
        for (int e = 0; e < 4; ++e)
#pragma unroll
            for (int pc = 0; pc < 2; ++pc) { u32x4 o; o.x = cvt_pk_bf16(v[8 * pc + 0][e], v[8 * pc + 1][e]); o.y = cvt_pk_bf16(v[8 * pc + 2][e], v[8 * pc + 3][e]);
                o.z = cvt_pk_bf16(v[8 * pc + 4][e], v[8 * pc + 5][e]); o.w = cvt_pk_bf16(v[8 * pc + 6][e], v[8 * pc + 7][e]);
                *(u32x4*)(WT + rows[e] + 16 * half + 8 * pc) = o; }
    }
}
constexpr int CI_IN = (DM / 64) * (INC / 128), CI_AP = (AW / 64) * (DM / 128), CI_HP = (HGW / 64) * (DM / 128), CI_OUT = (DM / 64) * (DM / 128), CI_FI = (DM / 64) * (2 * FFH / 128), CI_FO = (FFH / 64) * (DM / 128);
constexpr int N_CONV_ITEMS = CI_IN + CI_AP + CI_HP + CI_OUT + CI_FI + CI_FO;
__device__ __forceinline__ void p0_convert_item(Frame& F, int it) {
    int r = it;
    if (r < CI_IN) { p0_conv_item<1>(F.w_in, DM, INC, WSP(bf16_t, WS_WIN), r, F.lane); return; } r -= CI_IN;
    if (r < CI_AP) { p0_conv_item<0>(F.w_ap, AW, DM, WSP(bf16_t, WS_WAP), r, F.lane); return; } r -= CI_AP;
    if (r < CI_HP) { p0_conv_item<0>(F.w_hp, HGW, DM, WSP(bf16_t, WS_WHP), r, F.lane); return; } r -= CI_HP;
    if (r < CI_OUT) { p0_conv_item<0>(F.w_out, DM, DM, WSP(bf16_t, WS_WOUT), r, F.lane); return; } r -= CI_OUT;
    if (r < CI_FI) { p0_conv_item<2>(F.w_fi, DM, 2 * FFH, WSP(bf16_t, WS_WFI), r, F.lane); return; } r -= CI_FI;
    p0_conv_item<0>(F.w_fo, FFH, DM, WSP(bf16_t, WS_WFO), r, F.lane);
}
constexpr int N_MOD_ITEMS = NMODC / 64;

__device__ __forceinline__ double rope_rev(int f) {
    switch (f) { case 0: return 0.15915494309189535; case 1: return 0.03086376340470123; case 2: return 0.005985185712713705; case 3: return 0.001160663641240061;
                 case 4: return 0.00022507907903927653; case 5: return 4.364795279280289e-05; case 6: return 8.464330808241401e-06; default: return 1.6414262627950345e-06; }
}

__device__ __forceinline__ void p0_prologue(Frame& F) {
    for (int idx = blockIdx.x * 512 + F.tid; idx < MTOK * 8; idx += F.G * 512) {
        const int m = idx >> 3, f = idx & 7;
        const double rev = (double)F.positions[m] * rope_rev(f);
        const float fr = (float)(rev - floor(rev));
        float* rp = WSP(float, WS_ROPE) + (size_t)m * 16;
        rp[f] = __builtin_amdgcn_cosf(fr); rp[8 + f] = __builtin_amdgcn_sinf(fr);
        if (idx < HGW) { const float a0 = F.hg_lb[idx], a1 = F.hg_lb[HGW + idx]; WSP(float, WS_LB)[idx] = 1.0f / (1.0f + __expf(a1 - a0)); }
    }
    if ((int)blockIdx.x < N_MOD_ITEMS) {
        const int item = blockIdx.x;
        LAS float* cT = (LAS float*)F.lds + F.wave * 2048;
        LAS float* red = (LAS float*)(F.lds + 65536);
        const int k0 = F.wave * 256;
#pragma unroll 4
        for (int i = 0; i < 32; ++i) { const int idx = i * 64 + F.lane; cT[idx] = F.c[(idx & 7) * DM + k0 + (idx >> 3)]; }
        LDS_WAIT(); asm volatile("" ::: "memory");
        float acc[8];
#pragma unroll
        for (int b = 0; b < 8; ++b) acc[b] = 0.f;
        const float* wp = F.w_ada + (size_t)k0 * NMODC + item * 64 + F.lane;
#pragma unroll 16
        for (int k = 0; k < 256; ++k) {
            const float w = wp[(size_t)k * NMODC];
            const f32x4 c0 = *(const LAS f32x4*)(cT + k * 8), c1 = *(const LAS f32x4*)(cT + k * 8 + 4);
            acc[0] += w * c0[0]; acc[1] += w * c0[1]; acc[2] += w * c0[2]; acc[3] += w * c0[3];
            acc[4] += w * c1[0]; acc[5] += w * c1[1]; acc[6] += w * c1[2]; acc[7] += w * c1[3];
        }
#pragma unroll
        for (int b = 0; b < 8; ++b) red[(F.wave * 8 + b) * 64 + F.lane] = acc[b];
        __syncthreads();
        float s = F.b_ada[item * 64 + F.lane];
#pragma unroll
        for (int w = 0; w < 8; ++w) s += red[(w * 8 + F.wave) * 64 + F.lane];
        WSP(float, WS_MOD)[F.wave * NMODC + item * 64 + F.lane] = s;
        __syncthreads();
    }
    constexpr int CONV_EXTRA = 11;
    int first = 0;
    if ((int)F.G > N_MOD_ITEMS) {
        first = ((int)F.G - N_MOD_ITEMS) * CONV_EXTRA;
        if ((int)blockIdx.x >= N_MOD_ITEMS) for (int j = F.wave; j < CONV_EXTRA; j += NWAVES) p0_convert_item(F, ((int)blockIdx.x - N_MOD_ITEMS) * CONV_EXTRA + j);
    }
    for (int it = first + blockIdx.x * NWAVES + F.wave; it < N_CONV_ITEMS; it += F.G * NWAVES) p0_convert_item(F, it);
}

__device__ __forceinline__ void p1_rows(Frame& F) {
    const int gw = blockIdx.x * NWAVES + F.wave, NGW = F.G * NWAVES;
    bf16_t* XN = (bf16_t*)((unsigned char*)F.out + OUT_XN);
    for (int r0 = gw * 8; r0 < MTOK; r0 += NGW * 8) {
        const int b = r0 / SEQ;
        const float* mod = WSP(float, WS_MOD) + (size_t)b * NMODC;
        f32x4 ga[8], sh[8];
#pragma unroll
        for (int j = 0; j < 8; ++j) { const int col = 4 * F.lane + 256 * j;
            const f32x4 g = *(const f32x4*)(F.g_pre_mix + col), sc = *(const f32x4*)(mod + DM + col); sh[j] = *(const f32x4*)(mod + col); ga[j] = g * (1.0f + sc); }
        for (int r = r0; r < r0 + 8; ++r) {
            const float* xr = F.x + (size_t)r * DM;
            f32x4 v[8]; float ss = 0.f;
#pragma unroll
            for (int j = 0; j < 8; ++j) { v[j] = *(const f32x4*)(xr + 4 * F.lane + 256 * j); ss += (v[j][0] * v[j][0] + v[j][1] * v[j][1]) + (v[j][2] * v[j][2] + v[j][3] * v[j][3]); }
            const float rstd = rsqrtf(wave_sum(ss) * (1.0f / DM) + EPS);
            bf16_t* orow = XN + (size_t)r * DM;
#pragma unroll
            for (int j = 0; j < 8; ++j) { const f32x4 h = v[j] * rstd * ga[j] + sh[j]; u32x2 w; w.x = cvt_pk_bf16(h[0], h[1]); w.y = cvt_pk_bf16(h[2], h[3]); *(u32x2*)(orow + 4 * F.lane + 256 * j) = w; }
        }
    }
}

struct EpiG1 {
    unsigned char* ws; const float* rope; const float* lbv;
    static __device__ __forceinline__ bool keep_acc(const pg8::Unit&) { return false; }
    __device__ __forceinline__ void operator()(pg8::Acc& acc, const pg8::Unit& u, int wr, int wc, int fr, int fq) const {
        const int pn = u.pn; const int row0 = u.pm * 256 + wr * 64 + fr; const int cl = wc * 32 + 8 * fq;
        if (pn <= 4) {
            const bool dorope = ((wc & 1) == 0) && (fq < 2);
#pragma unroll
            for (int ai = 0; ai < 2; ++ai)
#pragma unroll
                for (int m = 0; m < 4; ++m) { const int row = row0 + ai * 128 + m * 16;
                    f32x4 cs = (f32x4){1.f, 1.f, 1.f, 1.f}, sn = (f32x4){0.f, 0.f, 0.f, 0.f};
                    if (dorope) { const float* rp = rope + (size_t)row * 16 + 4 * fq; cs = *(const f32x4*)rp; sn = *(const f32x4*)(rp + 8); }
#pragma unroll
                    for (int bj = 0; bj < 2; ++bj) { f32x4 v0 = acc[ai][bj][m][0], v1 = acc[ai][bj][m][1];
                        const bool isv = (pn == 4 && bj == 1);
                        if (dorope && !isv) { const f32x4 n0 = v0 * cs - v1 * sn, n1 = v1 * cs + v0 * sn; v0 = n0; v1 = n1; }
                        bf16_t* dst;
                        if (pn < 4) { v0 = v0 * QSCALE; v1 = v1 * QSCALE; dst = (bf16_t*)(ws + WS_QA) + (size_t)row * AW + pn * 256 + bj * 128 + cl; }
                        else dst = (bf16_t*)(ws + (bj == 0 ? WS_KA : WS_VA)) + (size_t)row * KVW + cl;
                        *(u32x4*)dst = pack8(v0, v1); } }
        } else if (pn <= 8) {
#pragma unroll
            for (int ai = 0; ai < 2; ++ai)
#pragma unroll
                for (int m = 0; m < 4; ++m) { const int row = row0 + ai * 128 + m * 16;
#pragma unroll
                    for (int bj = 0; bj < 2; ++bj) { f32x4 v0 = acc[ai][bj][m][0], v1 = acc[ai][bj][m][1];
#pragma unroll
                        for (int e = 0; e < 4; ++e) { v0[e] = v0[e] * fsigmoid(v0[e]); v1[e] = v1[e] * fsigmoid(v1[e]); }
                        *(u32x4*)((bf16_t*)(ws + WS_QH) + (size_t)row * HGW + (pn - 5) * 256 + bj * 128 + cl) = pack8(v0, v1); } }
        } else if (pn <= 12) {
#pragma unroll
            for (int bj = 0; bj < 2; ++bj) { const int col = (pn - 9) * 256 + bj * 128 + cl;
                const f32x4 lb0 = *(const f32x4*)(lbv + col), lb1 = *(const f32x4*)(lbv + col + 4);
#pragma unroll
                for (int ai = 0; ai < 2; ++ai)
#pragma unroll
                    for (int m = 0; m < 4; ++m) { const int row = row0 + ai * 128 + m * 16;
                        const f32x4 x0 = acc[ai][bj][m][0], x1 = acc[ai][bj][m][1]; f32x4 k0, k1, l0, l1;
#pragma unroll
                        for (int e = 0; e < 4; ++e) {
                            { const float xx = fminf(fmaxf(x0[e], -30.f), 30.f), ex = __expf(-xx), sg = frcp(1.0f + ex), om = 1.0f - lb0[e]; k0[e] = om * (ex * sg); l0[e] = __logf(lb0[e] + om * sg); }
                            { const float xx = fminf(fmaxf(x1[e], -30.f), 30.f), ex = __expf(-xx), sg = frcp(1.0f + ex), om = 1.0f - lb1[e]; k1[e] = om * (ex * sg); l1[e] = __logf(lb1[e] + om * sg); } }
                        *(u32x4*)((bf16_t*)(ws + WS_KH) + (size_t)row * HGW + col) = pack8(k0, k1);
                        *(u32x4*)((bf16_t*)(ws + WS_LF) + (size_t)row * HGW + col) = pack8(l0, l1); } }
        } else {
            bf16_t* base; int ldc, colt;
            if (pn <= 16) { base = (bf16_t*)(ws + WS_IH); ldc = HGW; colt = (pn - 13) * 256; }
            else if (pn <= 20) { base = (bf16_t*)(ws + WS_GH); ldc = HGW; colt = (pn - 17) * 256; }
            else if (pn <= 28) { base = (bf16_t*)(ws + WS_GA); ldc = DM; colt = (pn - 21) * 256; }
            else { base = (bf16_t*)(ws + WS_GHT); ldc = DM; colt = (pn - 29) * 256; }
            const bool sig = pn > 16;
#pragma unroll
            for (int ai = 0; ai < 2; ++ai)
#pragma unroll
                for (int m = 0; m < 4; ++m) { const int row = row0 + ai * 128 + m * 16;
#pragma unroll
                    for (int bj = 0; bj < 2; ++bj) { f32x4 v0 = acc[ai][bj][m][0], v1 = acc[ai][bj][m][1];
                        if (sig) {
#pragma unroll
                            for (int e = 0; e < 4; ++e) { v0[e] = fsigmoid(v0[e]); v1[e] = fsigmoid(v1[e]); } }
                        *(u32x4*)(base + (size_t)row * ldc + colt + bj * 128 + cl) = pack8(v0, v1); } }
        }
    }
};
struct EpiMerge {
    const bf16_t* ga; const bf16_t* gh; bf16_t* out;
    static __device__ __forceinline__ bool keep_acc(const pg8::Unit& u) { return u.sub == 0; }
    __device__ __forceinline__ void operator()(pg8::Acc& acc, const pg8::Unit& u, int wr, int wc, int fr, int fq) const {
        const int row0 = u.pm * 256 + wr * 64 + fr; const int col0 = u.pn * 256 + wc * 32 + 8 * fq;
#pragma unroll
        for (int ai = 0; ai < 2; ++ai)
#pragma unroll
            for (int m = 0; m < 4; ++m) { const size_t ro = (size_t)(row0 + ai * 128 + m * 16) * DM + col0;
#pragma unroll
                for (int bj = 0; bj < 2; ++bj) { f32x4 h0, h1; unpack8(*(const u32x4*)(gh + ro + bj * 128), h0, h1);
                    if (u.sub == 0) { f32x4 a0, a1; unpack8(*(const u32x4*)(ga + ro + bj * 128), a0, a1);
#pragma unroll
                        for (int e = 0; e < 4; ++e) { acc[ai][bj][m][0][e] *= a0[e] * frcp(h0[e]); acc[ai][bj][m][1][e] *= a1[e] * frcp(h1[e]); }
                    } else *(u32x4*)(out + ro + bj * 128) = pack8(acc[ai][bj][m][0] * h0, acc[ai][bj][m][1] * h1); } }
    }
};
struct EpiPlain {
    bf16_t* out; int ldc;
    static __device__ __forceinline__ bool keep_acc(const pg8::Unit&) { return false; }
    __device__ __forceinline__ void operator()(pg8::Acc& acc, const pg8::Unit& u, int wr, int wc, int fr, int fq) const {
        const int row0 = u.pm * 256 + wr * 64 + fr; const int col0 = u.pn * 256 + wc * 32 + 8 * fq;
#pragma unroll
        for (int ai = 0; ai < 2; ++ai)
#pragma unroll
            for (int m = 0; m < 4; ++m) { bf16_t* rp = out + (size_t)(row0 + ai * 128 + m * 16) * ldc + col0;
#pragma unroll
                for (int bj = 0; bj < 2; ++bj) *(u32x4*)(rp + bj * 128) = pack8(acc[ai][bj][m][0], acc[ai][bj][m][1]); }
    }
};
struct EpiSwiGLU {
    bf16_t* out;
    static __device__ __forceinline__ bool keep_acc(const pg8::Unit&) { return false; }
    __device__ __forceinline__ void operator()(pg8::Acc& acc, const pg8::Unit& u, int wr, int wc, int fr, int fq) const {
        const int row0 = u.pm * 256 + wr * 64 + fr; const int col0 = u.pn * 128 + wc * 32 + 8 * fq;
#pragma unroll
        for (int ai = 0; ai < 2; ++ai)
#pragma unroll
            for (int m = 0; m < 4; ++m) { f32x4 v0, v1;
#pragma unroll
                for (int e = 0; e < 4; ++e) { const float g0 = acc[ai][0][m][0][e], g1 = acc[ai][0][m][1][e]; v0[e] = g0 * fsigmoid(g0) * acc[ai][1][m][0][e]; v1[e] = g1 * fsigmoid(g1) * acc[ai][1][m][1][e]; }
                *(u32x4*)(out + (size_t)(row0 + ai * 128 + m * 16) * FFH + col0) = pack8(v0, v1); }
    }
};

__device__ __forceinline__ void attn_naive(Frame& F) {
    bf16_t* QA = WSP(bf16_t, WS_QA); const bf16_t* KA = WSP(bf16_t, WS_KA); const bf16_t* VA = WSP(bf16_t, WS_VA);
    for (int it = blockIdx.x * 512 + F.tid; it < MTOK * 16; it += F.G * 512) {
        const int m = it >> 4, hq = it & 15, b = m >> 11, s = m & 2047, kvh = hq >> 3;
        float q[64], o[64];
        bf16_t* qp = QA + (size_t)m * AW + hq * 64;
#pragma unroll
        for (int c = 0; c < 8; ++c) { const u32x4 w = *(const u32x4*)(qp + 8 * c); f32x4 a, bb; unpack8(w, a, bb);
#pragma unroll
            for (int e = 0; e < 4; ++e) { q[8 * c + e] = a[e]; q[8 * c + 4 + e] = bb[e]; } }
#pragma unroll
        for (int d = 0; d < 64; ++d) o[d] = 0.f;
        float mrun = F.sinks[hq] * LOG2E, den = 1.f;
        const int j0 = s >= 127 ? s - 127 : 0;
        for (int j = j0; j <= s; ++j) {
            const bf16_t* kr = KA + (size_t)(b * SEQ + j) * KVW + kvh * 64; const bf16_t* vr = VA + (size_t)(b * SEQ + j) * KVW + kvh * 64;
            float l = 0.f;
#pragma unroll
            for (int c = 0; c < 8; ++c) { f32x4 a, bb; unpack8(*(const u32x4*)(kr + 8 * c), a, bb);
#pragma unroll
                for (int e = 0; e < 4; ++e) { l += q[8 * c + e] * a[e]; l += q[8 * c + 4 + e] * bb[e]; } }
            const float mn = fmaxf(mrun, l), sc = exp2f(mrun - mn), p = exp2f(l - mn);
            den = den * sc + p; mrun = mn;
#pragma unroll
            for (int c = 0; c < 8; ++c) { f32x4 a, bb; unpack8(*(const u32x4*)(vr + 8 * c), a, bb);
#pragma unroll
                for (int e = 0; e < 4; ++e) { o[8 * c + e] = o[8 * c + e] * sc + p * a[e]; o[8 * c + 4 + e] = o[8 * c + 4 + e] * sc + p * bb[e]; } }
        }
        const float inv = 1.0f / den;
#pragma unroll
        for (int c = 0; c < 8; ++c) { f32x4 a, bb;
#pragma unroll
            for (int e = 0; e < 4; ++e) { a[e] = o[8 * c + e] * inv; bb[e] = o[8 * c + 4 + e] * inv; }
            *(u32x4*)(qp + 8 * c) = pack8(a, bb); }
    }
}
__device__ __forceinline__ void hgrn_naive_scan(Frame& F) {
    if (F.wave != 0 || (int)blockIdx.x >= 128) return;
    const int item = blockIdx.x, bh = item >> 1, vh = item & 1, b = bh >> 3, h = bh & 7;
    const bf16_t* QH = WSP(bf16_t, WS_QH); const bf16_t* KH = WSP(bf16_t, WS_KH); const bf16_t* LF = WSP(bf16_t, WS_LF); const bf16_t* IH = WSP(bf16_t, WS_IH);
    float* ORAW = (float*)((unsigned char*)F.out + OUT_ORAW);
    float st[128];
#pragma unroll
    for (int k = 0; k < 128; ++k) st[k] = 0.f;
    for (int t = 0; t < SEQ; ++t) {
        const size_t ro = (size_t)(b * SEQ + t) * HGW + h * 128;
        const float v = bf2f(IH[ro + vh * 64 + F.lane]);
        float o = 0.f;
#pragma unroll
        for (int c = 0; c < 16; ++c) { f32x4 q0, q1, k0, k1, l0, l1;
            unpack8(*(const u32x4*)(QH + ro + 8 * c), q0, q1); unpack8(*(const u32x4*)(KH + ro + 8 * c), k0, k1); unpack8(*(const u32x4*)(LF + ro + 8 * c), l0, l1);
#pragma unroll
            for (int e = 0; e < 4; ++e) {
                { const float f = exp2f(l0[e] * LOG2E); st[8 * c + e] = f * st[8 * c + e] + k0[e] * v; o += st[8 * c + e] * q0[e]; }
                { const float f = exp2f(l1[e] * LOG2E); st[8 * c + 4 + e] = f * st[8 * c + 4 + e] + k1[e] * v; o += st[8 * c + 4 + e] * q1[e]; } } }
        ORAW[ro + vh * 64 + F.lane] = o;
    }
}
__device__ __forceinline__ void hgrn_naive_finish(Frame& F) {
    const float* ORAW = (const float*)((unsigned char*)F.out + OUT_ORAW);
    bf16_t* HO = WSP(bf16_t, WS_QH); const bf16_t* GH = WSP(bf16_t, WS_GH);
    const int gw = blockIdx.x * NWAVES + F.wave, NGW = F.G * NWAVES;
    for (int it = gw; it < MTOK * 8; it += NGW) {
        const size_t ro = (size_t)(it >> 3) * HGW + (it & 7) * 128 + 2 * F.lane;
        const f32x2 o = *(const f32x2*)(ORAW + ro);
        const float rstd = rsqrtf(wave_sum(o[0] * o[0] + o[1] * o[1]) * (1.0f / 128.0f) + EPS);
        const f32x2 g = *(const f32x2*)(F.hg_norm + 2 * F.lane);
        const unsigned gw2 = *(const unsigned*)(GH + ro);
        *(unsigned*)(HO + ro) = cvt_pk_bf16(o[0] * rstd * g[0] * bflo(gw2), o[1] * rstd * g[1] * bfhi(gw2));
    }
}

__device__ __forceinline__ f32x16 mfma32(bf16x8 a, bf16x8 b, f32x16 c) { return __builtin_amdgcn_mfma_f32_32x32x16_bf16(a, b, c, 0, 0, 0); }
__device__ __forceinline__ v4i16_t tr_read(LAS unsigned char* p) { return __builtin_amdgcn_ds_read_tr16_b64_v4i16((LAS v4i16_t*)p); }
__device__ __forceinline__ bf16x8 cat44(v4i16_t lo, v4i16_t hi) { return (bf16x8){lo[0], lo[1], lo[2], lo[3], hi[0], hi[1], hi[2], hi[3]}; }
__device__ __forceinline__ bf16x8 acc_frag(const f32x16& x, int s) {
    u32x4 w; w.x = cvt_pk_bf16(x[8 * s + 0], x[8 * s + 1]); w.y = cvt_pk_bf16(x[8 * s + 2], x[8 * s + 3]); w.z = cvt_pk_bf16(x[8 * s + 4], x[8 * s + 5]); w.w = cvt_pk_bf16(x[8 * s + 6], x[8 * s + 7]);
    return __builtin_bit_cast(bf16x8, w);
}
__device__ __forceinline__ int crow(int r, int h) { return (r & 3) + 8 * (r >> 2) + 4 * h; }

constexpr int ATT_KS = 144, ATT_VS = 192, ATT_VOFF = 256 * ATT_KS;
__device__ __forceinline__ void attn_unit(Frame& F, int unit) {
    const int n = unit & 15, kvh = (unit >> 4) & 1, b = unit >> 5;
    const int lane = F.lane, c = lane & 31, h = lane >> 5, hq = kvh * 8 + F.wave;
    bf16_t* QA = WSP(bf16_t, WS_QA); const bf16_t* KA = WSP(bf16_t, WS_KA); const bf16_t* VA = WSP(bf16_t, WS_VA);
    LAS unsigned char* Ks = F.lds; LAS unsigned char* Vs = F.lds + ATT_VOFF;
    const long tok0 = (long)b * SEQ + (long)(n - 1) * 128;
#pragma unroll
    for (int i = 0; i < 4; ++i) { const int piece = F.tid + 512 * i, key = piece >> 3, ch = piece & 7;
        u32x4 kv = (u32x4){0u, 0u, 0u, 0u}, vv = (u32x4){0u, 0u, 0u, 0u};
        if (n > 0 || key >= 128) { const size_t go = (size_t)(tok0 + key) * KVW + kvh * 64 + ch * 8; kv = *(const u32x4*)(KA + go); vv = *(const u32x4*)(VA + go); }
        *(LAS u32x4*)(Ks + key * ATT_KS + ch * 16) = kv; *(LAS u32x4*)(Vs + key * ATT_VS + ch * 16) = vv; }
    __syncthreads();
    const float sink2 = F.sinks[hq] * LOG2E;
    const int g2 = (lane >> 4) & 1, q4 = (lane & 15) >> 2, p4 = lane & 3;
    for (int j = 0; j < 4; ++j) {
        bf16_t* qp = QA + (size_t)(b * SEQ + n * 128 + 32 * j + c) * AW + hq * 64;
        bf16x8 qf[4];
#pragma unroll
        for (int s = 0; s < 4; ++s) qf[s] = *(const bf16x8*)(qp + 16 * s + 8 * h);
        f32x16 S[5];
#pragma unroll
        for (int t = 0; t < 5; ++t) { const int kt = j + t;
#pragma unroll
            for (int r = 0; r < 16; ++r) S[t][r] = 0.f;
#pragma unroll
            for (int s = 0; s < 4; ++s) { const bf16x8 a = *(const LAS bf16x8*)(Ks + (32 * kt + c) * ATT_KS + (16 * s + 8 * h) * 2); S[t] = mfma32(a, qf[s], S[t]); } }
        float mx = sink2;
#pragma unroll
        for (int t = 0; t < 5; ++t) { const bool tile_ok = (n > 0) || (j + t >= 4);
#pragma unroll
            for (int r = 0; r < 16; ++r) { const int row = crow(r, h); const bool ok = tile_ok && (t == 0 ? (row > c) : (t == 4 ? (row <= c) : true));
                S[t][r] = ok ? S[t][r] : -INFINITY; mx = fmaxf(mx, S[t][r]); } }
        mx = fmaxf(mx, __shfl_xor(mx, 32));
        float sum = 0.f;
#pragma unroll
        for (int t = 0; t < 5; ++t)
#pragma unroll
            for (int r = 0; r < 16; ++r) { const float p = __builtin_amdgcn_exp2f(S[t][r] - mx); S[t][r] = p; sum += p; }
        sum += __shfl_xor(sum, 32); sum += __builtin_amdgcn_exp2f(sink2 - mx);
        f32x16 O[2];
#pragma unroll
        for (int r = 0; r < 16; ++r) { O[0][r] = 0.f; O[1][r] = 0.f; }
#pragma unroll
        for (int t = 0; t < 5; ++t) { const int kt = j + t;
#pragma unroll
            for (int s = 0; s < 2; ++s) { const bf16x8 pb = acc_frag(S[t], s);
#pragma unroll
                for (int dt = 0; dt < 2; ++dt) { LAS unsigned char* vp = Vs + (32 * kt + 16 * s + 4 * h + q4) * ATT_VS + (32 * dt + 16 * g2 + 4 * p4) * 2;
                    const v4i16_t lo = tr_read(vp), hi = tr_read(vp + 8 * ATT_VS);
                    O[dt] = mfma32(cat44(lo, hi), pb, O[dt]); } } }
        const float inv = 1.0f / sum;
#pragma unroll
        for (int dt = 0; dt < 2; ++dt)
#pragma unroll
            for (int g = 0; g < 4; ++g) { u32x2 w; w.x = cvt_pk_bf16(O[dt][4 * g] * inv, O[dt][4 * g + 1] * inv); w.y = cvt_pk_bf16(O[dt][4 * g + 2] * inv, O[dt][4 * g + 3] * inv);
                *(u32x2*)(qp + 32 * dt + 8 * g + 4 * h) = w; }
    }
    __syncthreads();
}

constexpr int HG_KUT_S = 144, HG_VS_S = 320, HG_ROW_S = 272;
constexpr int HG_TOT = 0, HG_SSQ = 2048, HG_VS = 4096, HG_KUT = HG_VS + 64 * HG_VS_S, HG_QI = HG_VS + 64 * HG_VS_S, HG_QS = HG_QI + 64 * HG_ROW_S, HG_KSC = HG_QS + 64 * HG_ROW_S;
__device__ __forceinline__ void hg_cumsum_regs(Frame& F, const bf16_t (&rl)[16], float (&bc)[16], float& bmid, float& bL) {
    const int k = F.tid & 127, seg = F.tid >> 7;
    LAS float* tot = (LAS float*)(F.lds + HG_TOT);
    float run = 0.f;
#pragma unroll
    for (int i = 0; i < 16; ++i) { run += bf2f(rl[i]); bc[i] = run; }
    tot[seg * 128 + k] = run;
    __syncthreads();
    const float t0 = tot[k], t1 = tot[128 + k], t2 = tot[256 + k], t3 = tot[384 + k];
    const float off = (seg > 0 ? t0 : 0.f) + (seg > 1 ? t1 : 0.f) + (seg > 2 ? t2 : 0.f);
#pragma unroll
    for (int i = 0; i < 16; ++i) bc[i] += off;
    bmid = t0 + t1; bL = (t0 + t1) + (t2 + t3);
}
#define HG_BASE(unit) ((size_t)((((unit) >> 5) >> 3) * SEQ + 64 * ((unit) & 31)) * HGW + (((unit) >> 5) & 7) * 128)
__device__ __forceinline__ void hgrn_passA(Frame& F) {
    const bf16_t* LF = WSP(bf16_t, WS_LF); const bf16_t* KH = WSP(bf16_t, WS_KH); const bf16_t* IH = WSP(bf16_t, WS_IH);
    const int k = F.tid & 127, seg = F.tid >> 7;
    const int lane = F.lane, c = lane & 31, hh = lane >> 5, g2 = (lane >> 4) & 1, q4 = (lane & 15) >> 2, p4 = lane & 3;
    const int kt = F.wave >> 1;
    int unit = blockIdx.x;
    if (unit >= 2048) return;
    bf16_t rl[16], rk[16]; u32x4 rv[2];
#define PA_LOAD(u) do { const size_t b_ = HG_BASE(u); \
        _Pragma("unroll") for (int i = 0; i < 16; ++i) { rl[i] = LF[b_ + (size_t)(16 * seg + i) * HGW + k]; rk[i] = KH[b_ + (size_t)(16 * seg + i) * HGW + k]; } \
        _Pragma("unroll") for (int i = 0; i < 2; ++i) { const int pc_ = F.tid + 512 * i; rv[i] = *(const u32x4*)(IH + b_ + (size_t)(pc_ >> 4) * HGW + (pc_ & 15) * 8); } } while (0)
    PA_LOAD(unit);
    for (; unit < 2048; unit += F.G) {
        float bc[16], bmid, bL;
        hg_cumsum_regs(F, rl, bc, bmid, bL);
        float ku[16];
#pragma unroll
        for (int i = 0; i < 16; ++i) ku[i] = bf2f(rk[i]) * __expf(bL - bc[i]);
        u32x4 w0, w1;
        w0.x = cvt_pk_bf16(ku[0], ku[1]); w0.y = cvt_pk_bf16(ku[2], ku[3]); w0.z = cvt_pk_bf16(ku[4], ku[5]); w0.w = cvt_pk_bf16(ku[6], ku[7]);
        w1.x = cvt_pk_bf16(ku[8], ku[9]); w1.y = cvt_pk_bf16(ku[10], ku[11]); w1.z = cvt_pk_bf16(ku[12], ku[13]); w1.w = cvt_pk_bf16(ku[14], ku[15]);
        *(LAS u32x4*)(F.lds + HG_KUT + k * HG_KUT_S + seg * 32) = w0; *(LAS u32x4*)(F.lds + HG_KUT + k * HG_KUT_S + seg * 32 + 16) = w1;
        if (seg == 0) WSP(float, WS_DEC)[(size_t)unit * 128 + k] = __expf(bL);
#pragma unroll
        for (int i = 0; i < 2; ++i) { const int pc = F.tid + 512 * i; *(LAS u32x4*)(F.lds + HG_VS + (pc >> 4) * HG_VS_S + (pc & 15) * 16) = rv[i]; }
        __syncthreads();
        if (unit + (int)F.G < 2048) PA_LOAD(unit + F.G);
        f32x16 acc[2];
#pragma unroll
        for (int r = 0; r < 16; ++r) { acc[0][r] = 0.f; acc[1][r] = 0.f; }
#pragma unroll
        for (int ks = 0; ks < 4; ++ks) { const bf16x8 a = *(const LAS bf16x8*)(F.lds + HG_KUT + (32 * kt + c) * HG_KUT_S + (16 * ks + 8 * hh) * 2);
#pragma unroll
            for (int e = 0; e < 2; ++e) { const int vt = 2 * (F.wave & 1) + e; LAS unsigned char* vp = F.lds + HG_VS + (16 * ks + 8 * hh + q4) * HG_VS_S + (32 * vt + 16 * g2 + 4 * p4) * 2;
                const v4i16_t lo = tr_read(vp), hi = tr_read(vp + 4 * HG_VS_S);
                acc[e] = mfma32(a, cat44(lo, hi), acc[e]); } }
        bf16_t* US = (bf16_t*)((unsigned char*)F.out + OUT_US) + (size_t)unit * 16384;
#pragma unroll
        for (int e = 0; e < 2; ++e) { const int v = 32 * (2 * (F.wave & 1) + e) + c;
#pragma unroll
            for (int g = 0; g < 4; ++g) { u32x2 w; w.x = cvt_pk_bf16(acc[e][4 * g], acc[e][4 * g + 1]); w.y = cvt_pk_bf16(acc[e][4 * g + 2], acc[e][4 * g + 3]);
                *(u32x2*)(US + v * 128 + 32 * kt + 8 * g + 4 * hh) = w; } }
    }
#undef PA_LOAD
    __syncthreads();
}
__device__ __forceinline__ void hgrn_passB(Frame& F) {
    const bf16_t* __restrict__ US = (const bf16_t*)((unsigned char*)F.out + OUT_US); bf16_t* __restrict__ SS = (bf16_t*)((unsigned char*)F.out + OUT_SS);
    const float* __restrict__ DEC = WSP(float, WS_DEC);
    LAS float* dl = (LAS float*)F.lds;
    for (int item = blockIdx.x; item < 256; item += F.G) {
        const int bh = item >> 2, vq = item & 3;
#pragma unroll
        for (int i = 0; i < 2; ++i) { const int i4 = F.tid + 512 * i; *(LAS f32x4*)(dl + i4 * 4) = *(const f32x4*)(DEC + (size_t)bh * 32 * 128 + i4 * 4); }
        __syncthreads();
        const int k8 = (F.tid & 15) * 8; const size_t eoff = (size_t)(32 * vq + (F.tid >> 4)) * 128 + k8;
        f32x4 s0 = (f32x4){0.f, 0.f, 0.f, 0.f}, s1 = s0;
        for (int c0 = 0; c0 < 32; c0 += 16) {
            u32x4 u[16];
#pragma unroll
            for (int i = 0; i < 16; ++i) u[i] = *(const u32x4*)(US + ((size_t)bh * 32 + c0 + i) * 16384 + eoff);
#pragma unroll
            for (int i = 0; i < 16; ++i) { *(u32x4*)(SS + ((size_t)bh * 32 + c0 + i) * 16384 + eoff) = pack8(s0, s1);
                const f32x4 d0 = *(const LAS f32x4*)(dl + (c0 + i) * 128 + k8), d1 = *(const LAS f32x4*)(dl + (c0 + i) * 128 + k8 + 4);
                f32x4 a, bb; unpack8(u[i], a, bb); s0 = d0 * s0 + a; s1 = d1 * s1 + bb; }
        }
        __syncthreads();
    }
}
__device__ __forceinline__ void hgrn_passC(Frame& F) {
    const bf16_t* LF = WSP(bf16_t, WS_LF); const bf16_t* KH = WSP(bf16_t, WS_KH); const bf16_t* IH = WSP(bf16_t, WS_IH); const bf16_t* GH = WSP(bf16_t, WS_GH);
    bf16_t* QH = WSP(bf16_t, WS_QH);
    const bf16_t* SSb = (const bf16_t*)((unsigned char*)F.out + OUT_SS);
    const int k = F.tid & 127, seg = F.tid >> 7;
    const int lane = F.lane, c = lane & 31, hh = lane >> 5, g2 = (lane >> 4) & 1, q4 = (lane & 15) >> 2, p4 = lane & 3;
    const int vt = F.wave & 3, tt = F.wave >> 2;
    int unit = blockIdx.x;
    if (unit >= 2048) return;
    bf16_t rl[16], rq[16], rk[16]; u32x4 rv[2];
#define PC_LOAD(u) do { const size_t b_ = HG_BASE(u); \
        _Pragma("unroll") for (int i = 0; i < 16; ++i) { const size_t go_ = b_ + (size_t)(16 * seg + i) * HGW + k; rl[i] = LF[go_]; rq[i] = QH[go_]; rk[i] = KH[go_]; } \
        _Pragma("unroll") for (int i = 0; i < 2; ++i) { const int pc_ = F.tid + 512 * i; rv[i] = *(const u32x4*)(IH + b_ + (size_t)(pc_ >> 4) * HGW + (pc_ & 15) * 8); } } while (0)
    PC_LOAD(unit);
    for (; unit < 2048; unit += F.G) {
        const size_t base = HG_BASE(unit);
        const size_t orow = base + (size_t)(32 * tt + c) * HGW;
        bf16x8 sa[8];
#pragma unroll
        for (int ks = 0; ks < 8; ++ks) sa[ks] = *(const bf16x8*)(SSb + (size_t)unit * 16384 + (32 * vt + c) * 128 + 16 * ks + 8 * hh);
        u32x2 gq[4];
#pragma unroll
        for (int g = 0; g < 4; ++g) gq[g] = *(const u32x2*)(GH + orow + 32 * vt + 8 * g + 4 * hh);
        float bc[16], bmid, bL;
        hg_cumsum_regs(F, rl, bc, bmid, bL);
#pragma unroll
        for (int i = 0; i < 16; ++i) { const int s = 16 * seg + i;
            const float q = bf2f(rq[i]), kk = bf2f(rk[i]);
            const float eI = __expf(bc[i]), eS = __expf(bc[i] - bmid), eK = __expf(bmid - bc[i]);
            *(LAS bf16_t*)(F.lds + HG_QI + s * HG_ROW_S + k * 2) = (bf16_t)(cvt_pk_bf16(q * eI, 0.f) & 0xffffu);
            *(LAS bf16_t*)(F.lds + HG_QS + s * HG_ROW_S + k * 2) = (bf16_t)(cvt_pk_bf16(q * eS, 0.f) & 0xffffu);
            *(LAS bf16_t*)(F.lds + HG_KSC + s * HG_ROW_S + k * 2) = (bf16_t)(cvt_pk_bf16(kk * eK, 0.f) & 0xffffu); }
#pragma unroll
        for (int i = 0; i < 2; ++i) { const int pc = F.tid + 512 * i; *(LAS u32x4*)(F.lds + HG_VS + (pc >> 4) * HG_VS_S + (pc & 15) * 16) = rv[i]; }
        __syncthreads();
        if (unit + (int)F.G < 2048) PC_LOAD(unit + F.G);
        f32x16 X[2];
#pragma unroll
        for (int st = 0; st < 2; ++st) {
#pragma unroll
            for (int r = 0; r < 16; ++r) X[st][r] = 0.f;
            if (st <= tt) {
#pragma unroll
                for (int ks = 0; ks < 8; ++ks) { const bf16x8 a = *(const LAS bf16x8*)(F.lds + HG_KSC + (32 * st + c) * HG_ROW_S + (16 * ks + 8 * hh) * 2);
                    const bf16x8 bq = *(const LAS bf16x8*)(F.lds + HG_QS + (32 * tt + c) * HG_ROW_S + (16 * ks + 8 * hh) * 2); X[st] = mfma32(a, bq, X[st]); }
                if (st == tt) {
#pragma unroll
                    for (int r = 0; r < 16; ++r) X[st][r] = (crow(r, hh) <= c) ? X[st][r] : 0.f; }
            }
        }
        f32x16 O;
#pragma unroll
        for (int r = 0; r < 16; ++r) O[r] = 0.f;
#pragma unroll
        for (int ks = 0; ks < 8; ++ks) { const bf16x8 bq = *(const LAS bf16x8*)(F.lds + HG_QI + (32 * tt + c) * HG_ROW_S + (16 * ks + 8 * hh) * 2); O = mfma32(sa[ks], bq, O); }
#pragma unroll
        for (int st = 0; st < 2; ++st) if (st <= tt) {
#pragma unroll
            for (int s2 = 0; s2 < 2; ++s2) { const bf16x8 pb = acc_frag(X[st], s2);
                LAS unsigned char* vp = F.lds + HG_VS + (32 * st + 16 * s2 + 4 * hh + q4) * HG_VS_S + (32 * vt + 16 * g2 + 4 * p4) * 2;
                const v4i16_t lo = tr_read(vp), hi = tr_read(vp + 8 * HG_VS_S);
                O = mfma32(cat44(lo, hi), pb, O); } }
        float ss = 0.f;
#pragma unroll
        for (int r = 0; r < 16; ++r) ss += O[r] * O[r];
        ss += __shfl_xor(ss, 32);
        LAS float* ssq = (LAS float*)(F.lds + HG_SSQ);
        if (hh == 0) ssq[(tt * 4 + vt) * 32 + c] = ss;
        __syncthreads();
        const float tot = (ssq[(tt * 4 + 0) * 32 + c] + ssq[(tt * 4 + 1) * 32 + c]) + (ssq[(tt * 4 + 2) * 32 + c] + ssq[(tt * 4 + 3) * 32 + c]);
        const float rstd = rsqrtf(tot * (1.0f / 128.0f) + EPS);
#pragma unroll
        for (int g = 0; g < 4; ++g) { const int v0 = 32 * vt + 8 * g + 4 * hh;
            const f32x4 hn = *(const f32x4*)(F.hg_norm + v0);
            u32x2 w; w.x = cvt_pk_bf16(O[4 * g] * rstd * hn[0] * bflo(gq[g].x), O[4 * g + 1] * rstd * hn[1] * bfhi(gq[g].x));
            w.y = cvt_pk_bf16(O[4 * g + 2] * rstd * hn[2] * bflo(gq[g].y), O[4 * g + 3] * rstd * hn[3] * bfhi(gq[g].y));
            *(u32x2*)(QH + orow + v0) = w; }
    }
#undef PC_LOAD
    __syncthreads();
}

__device__ __forceinline__ void rows2(Frame& F) {
    const int gw = blockIdx.x * NWAVES + F.wave, NGW = F.G * NWAVES;
    const bf16_t* Y = WSP(bf16_t, WS_Y); bf16_t* H2 = WSP(bf16_t, WS_H2);
    for (int r0 = gw * 8; r0 < MTOK; r0 += NGW * 8) {
        const int b = r0 / SEQ;
        const float* mod = WSP(float, WS_MOD) + (size_t)b * NMODC;
        f32x4 g1[8], ga[8], sh[8];
#pragma unroll
        for (int j = 0; j < 8; ++j) { const int col = 4 * F.lane + 256 * j;
            g1[j] = *(const f32x4*)(mod + 2 * DM + col) * *(const f32x4*)(F.g_post_mix + col);
            ga[j] = *(const f32x4*)(F.g_pre_ffn + col) * (1.0f + *(const f32x4*)(mod + 4 * DM + col)); sh[j] = *(const f32x4*)(mod + 3 * DM + col); }
        for (int r = r0; r < r0 + 8; ++r) {
            const float* xr = F.x + (size_t)r * DM; const bf16_t* yr = Y + (size_t)r * DM;
            f32x4 v[8], y[8]; float ss = 0.f;
#pragma unroll
            for (int j = 0; j < 8; ++j) { v[j] = *(const f32x4*)(xr + 4 * F.lane + 256 * j); const u32x2 w = *(const u32x2*)(yr + 4 * F.lane + 256 * j);
                y[j] = (f32x4){bflo(w.x), bfhi(w.x), bflo(w.y), bfhi(w.y)}; ss += (y[j][0] * y[j][0] + y[j][1] * y[j][1]) + (y[j][2] * y[j][2] + y[j][3] * y[j][3]); }
            const float rstd = rsqrtf(wave_sum(ss) * (1.0f / DM) + EPS);
            float s2 = 0.f; float* orow = F.out + (size_t)r * DM;
#pragma unroll
            for (int j = 0; j < 8; ++j) { v[j] = v[j] + g1[j] * (y[j] * rstd); *(f32x4*)(orow + 4 * F.lane + 256 * j) = v[j];
                s2 += (v[j][0] * v[j][0] + v[j][1] * v[j][1]) + (v[j][2] * v[j][2] + v[j][3] * v[j][3]); }
            const float rstd2 = rsqrtf(wave_sum(s2) * (1.0f / DM) + EPS);
            bf16_t* hrow = H2 + (size_t)r * DM;
#pragma unroll
            for (int j = 0; j < 8; ++j) { const f32x4 h = v[j] * rstd2 * ga[j] + sh[j]; u32x2 w; w.x = cvt_pk_bf16(h[0], h[1]); w.y = cvt_pk_bf16(h[2], h[3]); *(u32x2*)(hrow + 4 * F.lane + 256 * j) = w; }
        }
    }
}
__device__ __forceinline__ void rows3(Frame& F) {
    const int gw = blockIdx.x * NWAVES + F.wave, NGW = F.G * NWAVES;
    const bf16_t* Y2 = WSP(bf16_t, WS_Y2);
    for (int r0 = gw * 8; r0 < MTOK; r0 += NGW * 8) {
        const int b = r0 / SEQ;
        const float* mod = WSP(float, WS_MOD) + (size_t)b * NMODC;
        f32x4 g2[8];
#pragma unroll
        for (int j = 0; j < 8; ++j) { const int col = 4 * F.lane + 256 * j; g2[j] = *(const f32x4*)(mod + 5 * DM + col) * *(const f32x4*)(F.g_post_ffn + col); }
        for (int r = r0; r < r0 + 8; ++r) {
            float* orow = F.out + (size_t)r * DM; const bf16_t* yr = Y2 + (size_t)r * DM;
            f32x4 v[8], y[8]; float ss = 0.f;
#pragma unroll
            for (int j = 0; j < 8; ++j) { v[j] = *(const f32x4*)(orow + 4 * F.lane + 256 * j); const u32x2 w = *(const u32x2*)(yr + 4 * F.lane + 256 * j);
                y[j] = (f32x4){bflo(w.x), bfhi(w.x), bflo(w.y), bfhi(w.y)}; ss += (y[j][0] * y[j][0] + y[j][1] * y[j][1]) + (y[j][2] * y[j][2] + y[j][3] * y[j][3]); }
            const float rstd = rsqrtf(wave_sum(ss) * (1.0f / DM) + EPS);
#pragma unroll
            for (int j = 0; j < 8; ++j) *(f32x4*)(orow + 4 * F.lane + 256 * j) = v[j] + g2[j] * (y[j] * rstd);
        }
    }
}

constexpr int NPH = 12;
struct Args { const void* in[18]; float* out; unsigned char* ws; int ph_lo, ph_hi; };
__global__ void __launch_bounds__(NWAVES * 64, 2) fwd_kernel(Args args) {
    extern __shared__ __attribute__((aligned(16))) unsigned char lds_raw[];
    Frame F;
    F.lds = (LAS unsigned char*)lds_raw;
    F.tid = threadIdx.x; F.lane = F.tid & 63; F.wave = __builtin_amdgcn_readfirstlane(F.tid >> 6);
    F.G = gridDim.x; { const int bx = blockIdx.x; F.vcu = (F.G % 8 == 0) ? (bx % 8) * (F.G / 8) + bx / 8 : bx; }
    F.x = (const float*)args.in[0]; F.c = (const float*)args.in[1]; F.positions = (const int*)args.in[2]; F.w_ada = (const float*)args.in[3]; F.b_ada = (const float*)args.in[4];
    F.g_pre_mix = (const float*)args.in[5]; F.g_post_mix = (const float*)args.in[6]; F.g_pre_ffn = (const float*)args.in[7]; F.g_post_ffn = (const float*)args.in[8];
    F.w_in = (const float*)args.in[9]; F.sinks = (const float*)args.in[10]; F.w_ap = (const float*)args.in[11]; F.hg_lb = (const float*)args.in[12]; F.hg_norm = (const float*)args.in[13];
    F.w_hp = (const float*)args.in[14]; F.w_out = (const float*)args.in[15]; F.w_fi = (const float*)args.in[16]; F.w_fo = (const float*)args.in[17];
    F.out = args.out; F.ws = args.ws;
    volatile LAS unsigned* MISC = (volatile LAS unsigned*)(F.lds + MISC_OFF);
    for (int u = F.tid; u < (LDS_BYTES - LDSCTL_OFF) / 4; u += NWAVES * 64) ((LAS unsigned*)(F.lds + LDSCTL_OFF))[u] = 0u;
    __syncthreads();
    const int lo = args.ph_lo, hi = args.ph_hi;
    XcdBarrier bar; bar.bar = WSP(unsigned, WS_CTL) + CW_BAR; bar.x = 0; bar.st = nullptr;
    if (hi - lo > 1) bar = xcd_barrier_post(WSP(unsigned, WS_CTL) + CW_BAR, MISC + 8);
#define IN(k) (lo <= (k) && (k) < hi)
    unsigned long long pt_acc = 0ull, pt_s = 0ull;
#define PT0(k) do { if ((PROBE_MASK >> (k)) & 1) pt_s = __builtin_amdgcn_s_memrealtime(); } while (0)
#define PT1(k) do { if ((PROBE_MASK >> (k)) & 1) pt_acc += __builtin_amdgcn_s_memrealtime() - pt_s; } while (0)
#define REP(k) for (int rep_ = 0; rep_ < ((k) == PROBE_DOUBLE ? 2 : 1); ++rep_)
#define SEAM(k) do { if (IN(k) && IN((k) + 1)) xcd_barrier(bar); } while (0)

    PT0(0);
    if (IN(0)) { REP(0) { p0_prologue(F); if (PROBE_DOUBLE == 0) xcd_barrier(bar); } SEAM(0); }
    PT1(0);
    PT0(1);
    if (IN(1)) { p1_rows(F); SEAM(1); }
    PT1(1);
    PT0(2);
    if (IN(2)) REP(2) {
        pg8::SingleOrder S; S.so.init(MTOK, INC, F.G, (int)blockIdx.x); S.A = (const char*)F.out + OUT_XN; S.B = (const char*)(F.ws + WS_WIN); S.tstep = (size_t)256 * DM * 2;
        EpiG1 E{F.ws, WSP(float, WS_ROPE), WSP(float, WS_LB)};
        pg8::gemm_phase<EpiG1, pg8::SingleOrder, true, true>(F.lds, DM, S, E);
        SEAM(2);
    }
    PT1(2);
    PT0(3);
    if (IN(3)) {
#if NAIVE_HGRN
        hgrn_naive_scan(F);
#endif
#if NAIVE_ATTN
        attn_naive(F);
#else
        for (int u = blockIdx.x; u < NB * 2 * 16; u += F.G) attn_unit(F, u);
#endif
#if !NAIVE_HGRN
        hgrn_passA(F);
#endif
        SEAM(3);
    }
    PT1(3);
    PT0(4);
    if (IN(4)) {
#if NAIVE_HGRN
        hgrn_naive_finish(F);
#else
        hgrn_passB(F);
#endif
        SEAM(4);
    }
    PT1(4);
    PT0(5);
    if (IN(5)) {
#if !NAIVE_HGRN
        hgrn_passC(F);
#endif
        SEAM(5);
    }
    PT1(5);
    PT0(6);
    if (IN(6)) {
        pg8::DualOrder S; S.so.init(MTOK, DM, F.G, (int)blockIdx.x); S.A0 = (const char*)(F.ws + WS_QA); S.B0 = (const char*)(F.ws + WS_WAP); S.A1 = (const char*)(F.ws + WS_QH); S.B1 = (const char*)(F.ws + WS_WHP); S.tstep = (size_t)256 * AW * 2;
        EpiMerge E{WSP(bf16_t, WS_GA), WSP(bf16_t, WS_GHT), WSP(bf16_t, WS_MERGED)};
        pg8::gemm_phase<EpiMerge, pg8::DualOrder, true, true>(F.lds, AW, S, E);
        SEAM(6);
    }
    PT1(6);
    PT0(7);
    if (IN(7)) {
        pg8::SingleOrder S; S.so.init(MTOK, DM, F.G, (int)blockIdx.x); S.A = (const char*)(F.ws + WS_MERGED); S.B = (const char*)(F.ws + WS_WOUT); S.tstep = (size_t)256 * DM * 2;
        EpiPlain E{WSP(bf16_t, WS_Y), DM};
        pg8::gemm_phase<EpiPlain, pg8::SingleOrder, true, true>(F.lds, DM, S, E);
        SEAM(7);
    }
    PT1(7);
    PT0(8);
    if (IN(8)) { REP(8) rows2(F); SEAM(8); }
    PT1(8);
    PT0(9);
    if (IN(9)) REP(9) {
        pg8::SingleOrder S; S.so.init(MTOK, 2 * FFH, F.G, (int)blockIdx.x); S.A = (const char*)(F.ws + WS_H2); S.B = (const char*)(F.ws + WS_WFI); S.tstep = (size_t)256 * DM * 2;
        EpiSwiGLU E{WSP(bf16_t, WS_ACT)};
        pg8::gemm_phase<EpiSwiGLU, pg8::SingleOrder, true, true>(F.lds, DM, S, E);
        SEAM(9);
    }
    PT1(9);
    PT0(10);
    if (IN(10)) {
        pg8::SingleOrder S; S.so.init(MTOK, DM, F.G, (int)blockIdx.x); S.A = (const char*)(F.ws + WS_ACT); S.B = (const char*)(F.ws + WS_WFO); S.tstep = (size_t)256 * FFH * 2;
        EpiPlain E{WSP(bf16_t, WS_Y2), DM};
        pg8::gemm_phase<EpiPlain, pg8::SingleOrder, true, true>(F.lds, FFH, S, E);
        SEAM(10);
    }
    PT1(10);
    PT0(11);
    if (IN(11)) { rows3(F); }
    PT1(11);
    if (PROBE_MASK != 0 && blockIdx.x == 0 && F.tid == 0) { const unsigned long long te = __builtin_amdgcn_s_memrealtime(); while (__builtin_amdgcn_s_memrealtime() - te < pt_acc) __builtin_amdgcn_s_sleep(8); }
#undef IN
#undef SEAM
}

extern "C" void kernel_launch(void* const* d_in, const int* in_sizes, int n_in, void* d_out, int out_size, void* d_ws, size_t ws_size, hipStream_t stream) {
    static int grid = 0;
    if (grid == 0) {
        if (n_in != 18 || in_sizes[0] != MTOK * DM || out_size != MTOK * DM || ws_size < WS_END) { fprintf(stderr, "kernel_launch: unexpected shapes (n_in %d, out %d, ws %zu); nothing launched\n", n_in, out_size, ws_size); grid = -1; return; }
        int dev = 0, cus = 0, per_cu = 0;
        if (hipGetDevice(&dev) != hipSuccess || hipDeviceGetAttribute(&cus, hipDeviceAttributeMultiprocessorCount, dev) != hipSuccess) { grid = -1; return; }
        if (hipFuncSetAttribute((const void*)fwd_kernel, hipFuncAttributeMaxDynamicSharedMemorySize, LDS_BYTES) != hipSuccess) { fprintf(stderr, "kernel_launch: hipFuncSetAttribute failed\n"); grid = -1; return; }
        if (hipOccupancyMaxActiveBlocksPerMultiprocessor(&per_cu, (const void*)fwd_kernel, NWAVES * 64, LDS_BYTES) != hipSuccess || per_cu < 1) { fprintf(stderr, "kernel_launch: occupancy query says %d blocks per CU\n", per_cu); (void)hipGetLastError(); grid = -1; return; }
        grid = cus;
    }
    if (grid < 0) return;
    (void)hipMemsetAsync((char*)d_ws + WS_CTL, 0, CTL_ZERO_BYTES, stream);
    Args a{};
    for (int i = 0; i < 18; ++i) a.in[i] = d_in[i];
    a.out = (float*)d_out; a.ws = (unsigned char*)d_ws;
    if (MK_N_LAUNCHES == 1) { a.ph_lo = 0; a.ph_hi = NPH; hipLaunchKernelGGL(fwd_kernel, dim3(grid), dim3(NWAVES * 64), LDS_BYTES, stream, a); }
    else for (int p = 0; p < NPH; ++p) { a.ph_lo = p; a.ph_hi = p + 1; hipLaunchKernelGGL(fwd_kernel, dim3(grid), dim3(NWAVES * 64), LDS_BYTES, stream, a); }
}
```
